# Optimizing an MI355X kernel written in HIP

```python
import math
import jax, jax.numpy as jnp
from jax import lax
import numpy as np

D_MODEL = 2048
BATCH = 8
SEQ = 4096
DEPTH = 2

HEAD_DIM = 128
A_HEADS = 4
A_VDIM = 2 * HEAD_DIM
B_HEADS = 8
B_BRANCHES = ((128, 1), (512, 4), (2048, 16))
C_Q_HEADS = 16
C_KV_HEADS = 4
C_RADIUS = 128
Q_BLOCK = 128
N_EXPERTS = 16
EXPERT_HIDDEN = 2048
EC_CAPACITY_FACTOR = 2

N_EVEN = (DEPTH + 1) // 2
N_ODD = DEPTH // 2
DEEPNORM_ALPHA = (2.0 * DEPTH) ** 0.25
DEEPNORM_BETA = (8.0 * DEPTH) ** -0.25
LN_EPS = 1e-5
NEG = -1e30

A_QK = A_HEADS * 2 * HEAD_DIM
A_V = A_HEADS * A_VDIM
B_W = B_HEADS * HEAD_DIM
AB_IN = 2 * A_QK + A_V + 3 * B_W
AB_OUT = A_V + B_W
C_QW = C_Q_HEADS * HEAD_DIM
C_KVW = C_KV_HEADS * HEAD_DIM
C_IN = C_QW + 2 * C_KVW
C_OUT = C_QW

kernel_name = "hybrid_diff_dilated_swa_ec_moe_encoder"


def alibi_slopes(n):
    return jnp.asarray(np.array([2.0 ** (-8.0 * (i + 1) / n) for i in range(n)], dtype=np.float32))


def layer_norm(x, g, b):
    xf = x.astype(jnp.float32)
    mu = xf.mean(-1, keepdims=True)
    var = jnp.square(xf - mu).mean(-1, keepdims=True)
    return ((xf - mu) * lax.rsqrt(var + LN_EPS) * g + b).astype(x.dtype)


def rms_norm(x, g):
    xf = x.astype(jnp.float32)
    return (xf * lax.rsqrt(jnp.square(xf).mean(-1, keepdims=True) + LN_EPS) * g).astype(x.dtype)


def banded_attention(q, k, v, slopes, radius, dist_scale, sink=None):
    bsz, n, hkv, g, dh = q.shape
    blk = radius
    nb = -(-n // blk)
    n_pad = nb * blk
    qb = jnp.pad(q, ((0, 0), (0, n_pad - n), (0, 0), (0, 0), (0, 0))).reshape(bsz, nb, blk, hkv, g, dh)
    pad_kv = ((0, 0), (blk, n_pad - n + blk), (0, 0), (0, 0))
    kp = jnp.pad(k, pad_kv).reshape(bsz, nb + 2, blk, hkv, dh)
    vp = jnp.pad(v, pad_kv).reshape(bsz, nb + 2, blk, hkv, dh)

    def windows(t):
        return jnp.concatenate([t[:, :-2], t[:, 1:-1], t[:, 2:]], axis=2)

    kw, vw = windows(kp), windows(vp)
    rel = jnp.arange(3 * blk)[None, :] - blk - jnp.arange(blk)[:, None]
    kpos = (jnp.arange(nb)[:, None] - 1) * blk + jnp.arange(3 * blk)[None, :]
    mask = (jnp.abs(rel) <= radius)[None] & ((kpos >= 0) & (kpos < n))[:, None, :]
    dist = (dist_scale * jnp.abs(rel)).astype(jnp.float32)
    s = jnp.einsum('bnihgd,bnjhd->bnhgij', qb, kw).astype(jnp.float32) * (dh ** -0.5)
    s = s - slopes.astype(jnp.float32)[:, :, None, None] * dist
    s = jnp.where(mask[None, :, None, None], s, NEG)
    m = s.max(-1)
    if sink is not None:
        sk = sink.astype(jnp.float32)[None, None, :, :, None]
        m = jnp.maximum(m, sk)
    p = jnp.exp(s - m[..., None])
    denom = p.sum(-1)
    if sink is not None:
        denom = denom + jnp.exp(sk - m)
    out = jnp.einsum('bnhgij,bnjhd->bnihgd', (p / denom[..., None]).astype(v.dtype), vw)
    lse = m + jnp.log(denom)
    out = out.reshape(bsz, n_pad, hkv, g, dh)[:, :n]
    lse = jnp.moveaxis(lse, -1, 2).reshape(bsz, n_pad, hkv, g)[:, :n]
    return out, lse


def dilated_mixture(q, k, v, slopes):
    bsz, s, h, dh = q.shape
    outs, lses = [], []
    for window, dil in B_BRANCHES:
        ns = s // dil

        def fold(t):
            return t.reshape(bsz, ns, dil, h, dh).transpose(0, 2, 1, 3, 4).reshape(bsz * dil, ns, h, dh)

        o, lse = banded_attention(fold(q)[:, :, :, None], fold(k), fold(v), slopes[:, None],
                                  window // (2 * dil), dil)
        outs.append(o[:, :, :, 0].reshape(bsz, dil, ns, h, dh).transpose(0, 2, 1, 3, 4).reshape(bsz, s, h, dh))
        lses.append(lse[..., 0].reshape(bsz, dil, ns, h).transpose(0, 2, 1, 3).reshape(bsz, s, h))
    w = jax.nn.softmax(jnp.stack(lses), axis=0)
    return jnp.einsum('rbsh,rbshd->bshd', w.astype(q.dtype), jnp.stack(outs))


def diff_attention(q, k, v, lam, slopes):
    bsz, s, h, _, dh = q.shape
    nblk = s // Q_BLOCK
    qb = q.reshape(bsz, nblk, Q_BLOCK, h, 2, dh).transpose(1, 0, 2, 3, 4, 5)
    kpos = jnp.arange(s)
    sl = slopes[None, :, None, None, None]

    def block(args):
        qi, start = args
        sc = jnp.einsum('bihmd,bjhmd->bhmij', qi, k).astype(jnp.float32) * (dh ** -0.5)
        qpos = start + jnp.arange(Q_BLOCK)
        dist = jnp.abs(qpos[:, None] - kpos[None, :]).astype(jnp.float32)
        p = jax.nn.softmax(sc - sl * dist, axis=-1)
        wdiff = p[:, :, 0] - lam * p[:, :, 1]
        return jnp.einsum('bhij,bjhe->bihe', wdiff.astype(v.dtype), v)

    out = lax.map(block, (qb, jnp.arange(nblk) * Q_BLOCK))
    return out.transpose(1, 0, 2, 3, 4).reshape(bsz, s, h, 2 * dh)


def mixer_ab(h, w_in, w_out, lam_vecs, subln_g, layer_idx):
    bsz, s, _ = h.shape
    proj = h @ w_in
    cuts = [A_QK, 2 * A_QK, 2 * A_QK + A_V, 2 * A_QK + A_V + B_W, 2 * A_QK + A_V + 2 * B_W]
    aq, ak, av, bq, bk, bv = jnp.split(proj, cuts, axis=-1)
    lam_init = 0.8 - 0.6 * math.exp(-0.3 * layer_idx)
    lv = lam_vecs.astype(jnp.float32)
    lam = jnp.exp(jnp.sum(lv[0] * lv[1])) - jnp.exp(jnp.sum(lv[2] * lv[3])) + lam_init
    ya = diff_attention(aq.reshape(bsz, s, A_HEADS, 2, HEAD_DIM), ak.reshape(bsz, s, A_HEADS, 2, HEAD_DIM),
                        av.reshape(bsz, s, A_HEADS, A_VDIM), lam, alibi_slopes(A_HEADS))
    ya = rms_norm(ya, subln_g) * (1.0 - lam_init)
    yb = dilated_mixture(bq.reshape(bsz, s, B_HEADS, HEAD_DIM), bk.reshape(bsz, s, B_HEADS, HEAD_DIM),
                         bv.reshape(bsz, s, B_HEADS, HEAD_DIM), alibi_slopes(B_HEADS))
    y = jnp.concatenate([ya.reshape(bsz, s, A_V), yb.reshape(bsz, s, B_W)], axis=-1)
    return y @ w_out


def mixer_c(h, w_in, w_out, sink):
    bsz, s, _ = h.shape
    g = C_Q_HEADS // C_KV_HEADS
    q, k, v = jnp.split(h @ w_in, [C_QW, C_QW + C_KVW], axis=-1)
    o, _ = banded_attention(q.reshape(bsz, s, C_KV_HEADS, g, HEAD_DIM),
                            k.reshape(bsz, s, C_KV_HEADS, HEAD_DIM), v.reshape(bsz, s, C_KV_HEADS, HEAD_DIM),
                            alibi_slopes(C_Q_HEADS).reshape(C_KV_HEADS, g), C_RADIUS, 1,
                            sink.reshape(C_KV_HEADS, g))
    return o.reshape(bsz, s, C_OUT) @ w_out


def expert_choice_ffn(h, w_router, w_gate, w_up, w_down):
    bsz, s, d = h.shape
    cap = EC_CAPACITY_FACTOR * s // N_EXPERTS
    aff = jax.nn.softmax((h @ w_router).astype(jnp.float32), axis=-1)
    gsel, idx = lax.top_k(jnp.swapaxes(aff, 1, 2), cap)
    xg = jax.vmap(lambda hb, ib: hb[ib])(h, idx)
    hid = jax.nn.silu(jnp.einsum('becd,edf->becf', xg, w_gate)) * jnp.einsum('becd,edf->becf', xg, w_up)
    y = jnp.einsum('becf,efd->becd', hid, w_down) * gsel[..., None].astype(h.dtype)
    return jax.vmap(lambda ib, yb: jnp.zeros((s, d), yb.dtype).at[ib.reshape(-1)].add(yb.reshape(-1, d)))(idx, y)


def setup_inputs(seed: int = 0) -> dict:
    key = jax.random.key(seed)
    ks = jax.random.split(key, 17)
    f32 = jnp.float32

    def nrm(k, shape, scale):
        return jax.random.normal(k, shape, f32) * scale

    beta = DEEPNORM_BETA
    ab_col = jnp.asarray(np.concatenate([np.ones(2 * A_QK), np.full(A_V, beta), np.ones(2 * B_W),
                                         np.full(B_W, beta)]).astype(np.float32))
    c_col = jnp.asarray(np.concatenate([np.ones(C_QW + C_KVW), np.full(C_KVW, beta)]).astype(np.float32))
    return {
        "x": nrm(ks[0], (BATCH, SEQ, D_MODEL), 1.0),
        "c": nrm(ks[1], (BATCH, D_MODEL), 1.0),
        "ada_w": nrm(ks[2], (DEPTH, D_MODEL, 6 * D_MODEL), 0.5 * D_MODEL ** -0.5),
        "ada_b": nrm(ks[3], (DEPTH, 6 * D_MODEL), 0.02),
        "ln_g": 1.0 + nrm(ks[4], (DEPTH, 2, D_MODEL), 0.02),
        "ln_b": nrm(ks[5], (DEPTH, 2, D_MODEL), 0.02),
        "ab_w_in": nrm(ks[6], (N_EVEN, D_MODEL, AB_IN), D_MODEL ** -0.5) * ab_col,
        "ab_w_out": nrm(ks[7], (N_EVEN, AB_OUT, D_MODEL), AB_OUT ** -0.5 * beta),
        "diff_lambda": nrm(ks[8], (N_EVEN, 4, HEAD_DIM), 0.1),
        "diff_subln_g": 1.0 + nrm(ks[9], (N_EVEN, A_VDIM), 0.02),
        "c_w_in": nrm(ks[10], (N_ODD, D_MODEL, C_IN), D_MODEL ** -0.5) * c_col,
        "c_w_out": nrm(ks[11], (N_ODD, C_OUT, D_MODEL), C_OUT ** -0.5 * beta),
        "c_sink": nrm(ks[12], (N_ODD, C_Q_HEADS), 0.5),
        "router_w": nrm(ks[13], (DEPTH, D_MODEL, N_EXPERTS), D_MODEL ** -0.5),
        "w_gate": nrm(ks[14], (DEPTH, N_EXPERTS, D_MODEL, EXPERT_HIDDEN), D_MODEL ** -0.5),
        "w_up": nrm(ks[15], (DEPTH, N_EXPERTS, D_MODEL, EXPERT_HIDDEN), D_MODEL ** -0.5),
        "w_down": nrm(ks[16], (DEPTH, N_EXPERTS, EXPERT_HIDDEN, D_MODEL), EXPERT_HIDDEN ** -0.5 * beta),
    }


def reference(x, c, ada_w, ada_b, ln_g, ln_b, ab_w_in, ab_w_out, diff_lambda, diff_subln_g,
              c_w_in, c_w_out, c_sink, router_w, w_gate, w_up, w_down):
    cs = jax.nn.silu(c)
    for l in range(DEPTH):
        mod = (cs @ ada_w[l] + ada_b[l])[:, None, :]
        sh1, sc1, g1, sh2, sc2, g2 = jnp.split(mod, 6, axis=-1)
        h = x * (1.0 + sc1) + sh1
        i = l // 2
        if l % 2 == 0:
            y = mixer_ab(h, ab_w_in[i], ab_w_out[i], diff_lambda[i], diff_subln_g[i], l)
        else:
            y = mixer_c(h, c_w_in[i], c_w_out[i], c_sink[i])
        x = layer_norm(DEEPNORM_ALPHA * x + g1 * y, ln_g[l, 0], ln_b[l, 0])
        h = x * (1.0 + sc2) + sh2
        y = expert_choice_ffn(h, router_w[l], w_gate[l], w_up[l], w_down[l])
        x = layer_norm(DEEPNORM_ALPHA * x + g2 * y, ln_g[l, 1], ln_b[l, 1])
    return x
```

```cpp
#include <hip/hip_runtime.h>
#include <cstdio>
#include <cstdint>
#ifndef MK_SINGLE
#define MK_SINGLE 1
#endif
namespace pg8 {
#define PG8_LAS __attribute__((address_space(3)))
typedef unsigned short bf16_t;
typedef short bf16x8 __attribute__((ext_vector_type(8)));
typedef float f32x4 __attribute__((ext_vector_type(4)));
typedef unsigned u32x4 __attribute__((ext_vector_type(4)));
typedef int i32x4 __attribute__((ext_vector_type(4)));
typedef int i32x8 __attribute__((ext_vector_type(8)));
constexpr int BM = 256, BK = 64, HALF = 128, HTB = HALF * BK * 2  , STAGE_BYTES = 8 * HTB, NXCD = 8, WGM = 8;

__host__ __device__ __forceinline__ int lds_byte(int r, int c) { const int st = (r >> 4) * 2 + (c >> 5), rr = r & 15, cc = c & 31, ob = rr * 64 + cc * 2; return st * 1024 + (ob ^ (((ob >> 9) & 1) << 5)); }
__host__ __device__ __forceinline__ void stage_rc(int b, int& R, int& C) { const int st = b / 1024, sb = b % 1024, swz = sb ^ (((sb >> 9) & 1) << 5); R = (st >> 1) * 16 + swz / 64; C = (st & 1) * 32 + (swz % 64) / 2; }
__host__ __device__ __forceinline__ int perm32(int rho) { const int n = rho >> 4, i = rho & 15; return 8 * (i >> 2) + 4 * n + (i & 3); }

struct Unit { int pm, pn; };
struct Gemm { const bf16_t* A; const bf16_t* Bt; int M, N, K; const unsigned* rowoff; };

struct StaticOrder {
    int nM, nN, nwg, G, c;
    __host__ __device__ void init(int M, int N, int G_, int c_) { nM = M / BM; nN = N / BM; nwg = nM * nN; G = G_; c = c_; }
    __host__ __device__ bool next(int i, Unit& u) const {
        const long L = (long)i * G + c; if (L >= nwg) return false;
        int wgid = (int)L; { const int q = nwg / NXCD, r = nwg % NXCD, xcd = wgid % NXCD, off = wgid / NXCD; wgid = (xcd < r ? xcd * (q + 1) : r * (q + 1) + (xcd - r) * q) + off; }
        const int nig = WGM * nN, gid = wgid / nig, fm = gid * WGM, gsz = (nM - fm) < WGM ? (nM - fm) : WGM;
        u.pm = fm + ((wgid % nig) % gsz); u.pn = (wgid % nig) / gsz; return true;
    }
    __device__ __forceinline__ void a_ready(const Unit&) const {}
    __device__ __forceinline__ void done(const Unit&) const {}
};

__device__ __forceinline__ unsigned cvt_pk_bf16(float lo, float hi) { unsigned r; asm volatile("v_cvt_pk_bf16_f32 %0, %1, %2" : "=v"(r) : "v"(lo), "v"(hi)); return r; }
typedef float f32x2 __attribute__((ext_vector_type(2)));

struct EpiBf16 {
    static constexpr bool PERM = true, AFTER_DRAIN = false;
    bf16_t* O; int ldc; int pnmask; float oscale;
    __device__ __forceinline__ void operator()(const f32x4 (&acc)[2][2][4][2], const Unit& u, int wr, int wc, int fr, int fq) const {
        const int row0 = u.pm * BM + wr * 64 + fr; const int col0 = (u.pn & pnmask) * BM + wc * 32 + 8 * fq;
#pragma unroll
        for (int ai = 0; ai < 2; ++ai)
#pragma unroll
            for (int m = 0; m < 4; ++m) { bf16_t* rowp = O + (size_t)(row0 + ai * HALF + m * 16) * ldc + col0;
#pragma unroll
                for (int bj = 0; bj < 2; ++bj) { const f32x4 v0 = acc[ai][bj][m][0] * oscale, v1 = acc[ai][bj][m][1] * oscale;
                    u32x4 w; w.x = cvt_pk_bf16(v0[0], v0[1]); w.y = cvt_pk_bf16(v0[2], v0[3]); w.z = cvt_pk_bf16(v1[0], v1[1]); w.w = cvt_pk_bf16(v1[2], v1[3]);
                    *(u32x4*)(rowp + bj * HALF) = w; } }
    }
};
struct EpiF8 {
    static constexpr bool PERM = true, AFTER_DRAIN = false;
    unsigned char* O; int ldc; int pnmask; float oscale;
    __device__ __forceinline__ void operator()(const f32x4 (&acc)[2][2][4][2], const Unit& u, int wr, int wc, int fr, int fq) const {
        const int row0 = u.pm * BM + wr * 64 + fr; const int col0 = (u.pn & pnmask) * BM + wc * 32 + 8 * fq;
        typedef int i32x2 __attribute__((ext_vector_type(2)));
#pragma unroll
        for (int ai = 0; ai < 2; ++ai)
#pragma unroll
            for (int m = 0; m < 4; ++m) { unsigned char* rowp = O + (size_t)(row0 + ai * HALF + m * 16) * ldc + col0;
#pragma unroll
                for (int bj = 0; bj < 2; ++bj) { const f32x4 lo4 = {-448.f, -448.f, -448.f, -448.f}, hi4 = {448.f, 448.f, 448.f, 448.f};
                    const f32x4 v0 = __builtin_elementwise_min(__builtin_elementwise_max(acc[ai][bj][m][0] * oscale, lo4), hi4), v1 = __builtin_elementwise_min(__builtin_elementwise_max(acc[ai][bj][m][1] * oscale, lo4), hi4);
                    int w0 = __builtin_amdgcn_cvt_pk_fp8_f32(v0[0], v0[1], 0, false); w0 = __builtin_amdgcn_cvt_pk_fp8_f32(v0[2], v0[3], w0, true);
                    int w1 = __builtin_amdgcn_cvt_pk_fp8_f32(v1[0], v1[1], 0, false); w1 = __builtin_amdgcn_cvt_pk_fp8_f32(v1[2], v1[3], w1, true);
                    *(i32x2*)(rowp + bj * HALF) = (i32x2){w0, w1}; } }
    }
};
template <bool F8OUT> struct EpiSwiGLU {
    static constexpr bool PERM = true, AFTER_DRAIN = false;
    bf16_t* O; int ldc; int pnmask; float oscale; float iscale;
    __device__ __forceinline__ static float silu_mul(float g, float u) { const float e = __builtin_amdgcn_exp2f(-1.4426950408889634f * g); return g * __builtin_amdgcn_rcpf(1.0f + e) * u; }
    __device__ __forceinline__ void operator()(const f32x4 (&acc)[2][2][4][2], const Unit& u, int wr, int wc, int fr, int fq) const {
        const int row0 = u.pm * BM + wr * 64 + fr; const int col0 = (u.pn & pnmask) * HALF + wc * 32 + 8 * fq;
#pragma unroll
        for (int ai = 0; ai < 2; ++ai)
#pragma unroll
            for (int m = 0; m < 4; ++m) { bf16_t* rowp = O + (size_t)(row0 + ai * HALF + m * 16) * ldc + col0;
                if constexpr (F8OUT) {
                    float h[8]; const float kt = -1.4426950408889634f * iscale, kd = 1.0f / (iscale * iscale * oscale);
#pragma unroll
                    for (int n = 0; n < 2; ++n) { const f32x4 G = acc[ai][0][m][n], U = acc[ai][1][m][n];
#pragma unroll
                        for (int hh = 0; hh < 2; ++hh) { const f32x2 gg = {G[2 * hh], G[2 * hh + 1]}, uu = {U[2 * hh], U[2 * hh + 1]};
                            const f32x2 t = gg * kt; f32x2 e; e.x = __builtin_amdgcn_exp2f(t.x); e.y = __builtin_amdgcn_exp2f(t.y);
                            const f32x2 d = e * kd + kd; f32x2 r; r.x = __builtin_amdgcn_rcpf(d.x); r.y = __builtin_amdgcn_rcpf(d.y);
                            const f32x2 p = (gg * uu) * r;
                            h[4 * n + 2 * hh] = __builtin_fminf(__builtin_fmaxf(p.x, -448.f), 448.f); h[4 * n + 2 * hh + 1] = __builtin_fminf(__builtin_fmaxf(p.y, -448.f), 448.f); } }
                    int w0 = __builtin_amdgcn_cvt_pk_fp8_f32(h[0], h[1], 0, false); w0 = __builtin_amdgcn_cvt_pk_fp8_f32(h[2], h[3], w0, true);
                    int w1 = __builtin_amdgcn_cvt_pk_fp8_f32(h[4], h[5], 0, false); w1 = __builtin_amdgcn_cvt_pk_fp8_f32(h[6], h[7], w1, true);
                    typedef int i32x2 __attribute__((ext_vector_type(2)));
                    *(i32x2*)((unsigned char*)O + (size_t)(row0 + ai * HALF + m * 16) * ldc + col0) = (i32x2){w0, w1};
                } else {
                const f32x4 g0 = acc[ai][0][m][0] * iscale, g1 = acc[ai][0][m][1] * iscale, u0 = acc[ai][1][m][0] * iscale, u1 = acc[ai][1][m][1] * iscale;
                u32x4 w; w.x = cvt_pk_bf16(silu_mul(g0[0], u0[0]), silu_mul(g0[1], u0[1])); w.y = cvt_pk_bf16(silu_mul(g0[2], u0[2]), silu_mul(g0[3], u0[3]));
                w.z = cvt_pk_bf16(silu_mul(g1[0], u1[0]), silu_mul(g1[1], u1[1])); w.w = cvt_pk_bf16(silu_mul(g1[2], u1[2]), silu_mul(g1[3], u1[3]));
                *(u32x4*)rowp = w; } }
    }
};
struct EpiF32 {
    static constexpr bool PERM = false, AFTER_DRAIN = false;
    float* O; int ldc;
    __device__ __forceinline__ void operator()(const f32x4 (&acc)[2][2][4][2], const Unit& u, int wr, int wc, int fr, int fq) const {
        const int row0 = u.pm * BM + wr * 64 + fr; const int col0 = u.pn * BM + wc * 32 + 4 * fq;
#pragma unroll
        for (int ai = 0; ai < 2; ++ai)
#pragma unroll
            for (int m = 0; m < 4; ++m) { float* rowp = O + (size_t)(row0 + ai * HALF + m * 16) * ldc + col0;
#pragma unroll
                for (int bj = 0; bj < 2; ++bj)
#pragma unroll
                    for (int n = 0; n < 2; ++n) *(f32x4*)(rowp + bj * HALF + n * 16) = acc[ai][bj][m][n]; }
    }
};
template <int NNL> struct GroupedOrder {
    int G, c;
    __device__ void init(int G_, int c_) { G = G_; c = c_; }
    __device__ bool next(int i, Unit& u) const {
        const int L = i * G + c; if (L >= 16 * 16 * NNL) return false;
        const int rnd = L >> 8, w = L & 255, x = w & 7, j = w >> 3;
        int e, rt, ct;
        if (NNL == 16) { e = rnd; rt = 4 * (x >> 1) + (j & 3); ct = 8 * (x & 1) + (j >> 2); }
        else           { e = 2 * rnd + (x >> 2); rt = 4 * (x & 3) + (j & 3); ct = j >> 2; }
        const int b = rt >> 1, half = rt & 1;
        u.pm = (b * 16 + e) * 2 + half; u.pn = e * NNL + ct; return true;
    }
    __device__ __forceinline__ void a_ready(const Unit&) const {}
    __device__ __forceinline__ void done(const Unit&) const {}
};
template <class Epi, class Sched, bool ALIGN_EPI = false, bool SP2 = false, bool F8 = false, bool GA = false>
__device__ __forceinline__ void gemm_phase(PG8_LAS unsigned char* lds, const Gemm g, const Sched& S, const Epi& E, const int wave0  ) {
    int tid = wave0 * 64 + ({ int l_; asm volatile("v_mbcnt_lo_u32_b32 %0, -1, 0\n\tv_mbcnt_hi_u32_b32 %0, -1, %0" : "=v"(l_)); l_; });
    const int wid = __builtin_amdgcn_readfirstlane(tid >> 6), lane = tid & 63, wr = wid >> 2, wc = wid & 3, fr = lane & 15, fq = lane >> 4;
    const int K = g.K, nt = K / BK;
    unsigned voffA[2], voffB[2];
#pragma unroll
    for (int i = 0; i < 2; ++i) { int R, C; stage_rc(tid * 16 + i * 8192, R, C); const int Rb = Epi::PERM ? ((R & ~31) + perm32(R & 31)) : R;
        voffA[i] = (unsigned)(R * K + C) * 2u; voffB[i] = (unsigned)(Rb * K + C) * 2u; }
    const size_t kstep = (size_t)(BK * 2);
    const size_t hstep = (size_t)HALF * K * 2;
    const size_t tstep = 2 * hstep;
    const size_t hstepA = GA ? 0 : hstep, tstepA = GA ? 0 : tstep;
    const unsigned ldsw = (unsigned)wid * 1024u;
    const int aoff = lds_byte(wr * 64 + fr, fq * 8), boff = lds_byte(wc * 32 + fr, fq * 8);
#define PG8_SA(b, h) (((b) * 2 + (h)) * HTB)
#define PG8_SB(b, h) ((4 + (b) * 2 + (h)) * HTB)
    const __amdgpu_buffer_rsrc_t rsA = __builtin_amdgcn_make_buffer_rsrc((void*)g.A, 0, 0x7FFFFFFF, 0x00020000), rsB = __builtin_amdgcn_make_buffer_rsrc((void*)g.Bt, 0, 0x7FFFFFFF, 0x00020000);
#define PG8_STAGE_X(rs, base0, bufoff, gbase, voff) do { const int so_ = (int)((const char*)(gbase) - (const char*)(base0)); _Pragma("unroll") for (int _i = 0; _i < 2; ++_i) \
        __builtin_amdgcn_raw_ptr_buffer_load_lds(rs, (PG8_LAS void*)(lds + (bufoff) + ldsw + _i * 8192), 16, (int)(voff)[_i], so_, 0, 0); } while (0)
#define PG8_STAGE_A(bufoff, gbase, voff) PG8_STAGE_X(rsA, g.A, bufoff, gbase, voff)
    static_assert(!GA || SP2, "gathered A rows: SP2 loop only");
    unsigned vg[2][2], vgn[2][2]; int gR[2]; unsigned gC[2]; constexpr int GA_LDS_OFF = 132096;
    const __amdgpu_buffer_rsrc_t rsR = __builtin_amdgcn_make_buffer_rsrc((void*)(GA ? (const void*)g.rowoff : (const void*)g.A), 0, 0x7FFFFFFF, 0x00020000);
    if constexpr (GA) {
#pragma unroll
        for (int i = 0; i < 2; ++i) { int R, C; stage_rc(tid * 16 + i * 8192, R, C); gR[i] = R; gC[i] = (unsigned)C * 2u; } }
#define PG8_STA(bufoff, h, nx, gbase) do { if constexpr (GA) { const int so_ = (int)((const char*)(gbase) - (const char*)g.A); _Pragma("unroll") for (int _i = 0; _i < 2; ++_i) \
            __builtin_amdgcn_raw_ptr_buffer_load_lds(rsA, (PG8_LAS void*)(lds + (bufoff) + ldsw + _i * 8192), 16, (int)((nx) ? vgn[h][_i] : vg[h][_i]), so_, 0, 0); } \
        else PG8_STAGE_X(rsA, g.A, bufoff, gbase, voffA); } while (0)
#define PG8_STAGE_B(bufoff, gbase, voff) PG8_STAGE_X(rsB, g.Bt, bufoff, gbase, voff)
#define PG8_LDA(dst, b, h) do { if constexpr (F8) { _Pragma("unroll") for (int m = 0; m < 4; ++m) { const i32x4 lo_ = *(const PG8_LAS i32x4*)(lds + PG8_SA(b, h) + aoff + m * 2048), hi_ = *(const PG8_LAS i32x4*)(lds + PG8_SA(b, h) + aoff + m * 2048 + 1024); \
            dst##8[m] = __builtin_shufflevector(lo_, hi_, 0, 1, 2, 3, 4, 5, 6, 7); } } \
        else { _Pragma("unroll") for (int m = 0; m < 4; ++m) _Pragma("unroll") for (int k = 0; k < 2; ++k) dst[m][k] = *(const PG8_LAS bf16x8*)(lds + PG8_SA(b, h) + aoff + m * 2048 + k * 1024); } } while (0)
#define PG8_LDB(dst, b, h) do { if constexpr (F8) { _Pragma("unroll") for (int n = 0; n < 2; ++n) { const i32x4 lo_ = *(const PG8_LAS i32x4*)(lds + PG8_SB(b, h) + boff + n * 2048), hi_ = *(const PG8_LAS i32x4*)(lds + PG8_SB(b, h) + boff + n * 2048 + 1024); \
            dst##8[n] = __builtin_shufflevector(lo_, hi_, 0, 1, 2, 3, 4, 5, 6, 7); } } \
        else { _Pragma("unroll") for (int n = 0; n < 2; ++n) _Pragma("unroll") for (int k = 0; k < 2; ++k) dst[n][k] = *(const PG8_LAS bf16x8*)(lds + PG8_SB(b, h) + boff + n * 2048 + k * 1024); } } while (0)
#define PG8_MMA(ai, bj, At, Bt) do { __builtin_amdgcn_s_setprio(1); \
        if constexpr (F8) { _Pragma("unroll") for (int m = 0; m < 4; ++m) _Pragma("unroll") for (int n = 0; n < 2; ++n) \
            asm volatile("v_mfma_f32_16x16x128_f8f6f4 %0, %1, %2, %0" : "+v"(acc[ai][bj][m][n]) : "v"(Bt##8[n]), "v"(At##8[m])); }   \
        else { _Pragma("unroll") for (int m = 0; m < 4; ++m) _Pragma("unroll") for (int n = 0; n < 2; ++n) _Pragma("unroll") for (int k = 0; k < 2; ++k) \
            acc[ai][bj][m][n] = __builtin_amdgcn_mfma_f32_16x16x32_bf16(Bt[n][k], At[m][k], acc[ai][bj][m][n], 0, 0, 0); } \
        __builtin_amdgcn_s_setprio(0); } while (0)
#define PG8_WAIT_V(n) asm volatile("s_waitcnt vmcnt(" #n ")" ::: "memory")
#define PG8_WAIT_L(n) asm volatile("s_waitcnt lgkmcnt(" #n ")" ::: "memory")
#define PG8_BAR __builtin_amdgcn_s_barrier()
#define PG8_SCHED __builtin_amdgcn_sched_barrier(0)
    Unit cur, nxt; int ui = 0;
    if (!S.next(0, cur)) return;
    f32x4 acc[2][2][4][2];
#pragma unroll
    for (int a = 0; a < 2; ++a)
#pragma unroll
        for (int b = 0; b < 2; ++b)
#pragma unroll
            for (int m = 0; m < 4; ++m)
#pragma unroll
                for (int n = 0; n < 2; ++n) acc[a][b][m][n] = (f32x4){0.f, 0.f, 0.f, 0.f};
    bf16x8 At[4][2], B0[2][2], B1[2][2]; i32x8 At8[4], B08[2], B18[2];
    const char* cA = (const char*)g.A + (size_t)cur.pm * tstepA; const char* cB = (const char*)g.Bt + (size_t)cur.pn * tstep;
    if constexpr (GA) {
#pragma unroll
        for (int h = 0; h < 2; ++h)
#pragma unroll
            for (int i = 0; i < 2; ++i) vg[h][i] = g.rowoff[cur.pm * BM + h * HALF + gR[i]] + gC[i]; }
    S.a_ready(cur);
    if constexpr (SP2) {
        PG8_STAGE_B(PG8_SB(0, 0), cB, voffB); PG8_STAGE_B(PG8_SB(0, 1), cB + hstep, voffB); PG8_STA(PG8_SA(0, 0), 0, false, cA); PG8_STA(PG8_SA(0, 1), 1, false, cA + hstepA);
        if (wr == 1) PG8_BAR;
        PG8_WAIT_V(2); PG8_BAR;
        PG8_STAGE_B(PG8_SB(1, 0), cB + kstep, voffB); PG8_STA(PG8_SA(1, 0), 0, false, cA + kstep); PG8_STAGE_B(PG8_SB(1, 1), cB + hstep + kstep, voffB);
        PG8_WAIT_V(6); PG8_BAR;
    } else {
        PG8_STAGE_B(PG8_SB(0, 0), cB, voffB); PG8_STAGE_A(PG8_SA(0, 0), cA, voffA); PG8_STAGE_B(PG8_SB(0, 1), cB + hstep, voffB); PG8_STAGE_A(PG8_SA(0, 1), cA + hstep, voffA);
        if (wr == 1) PG8_BAR;
        PG8_WAIT_V(4); PG8_BAR;
        PG8_STAGE_B(PG8_SB(1, 0), cB + kstep, voffB); PG8_STAGE_A(PG8_SA(1, 0), cA + kstep, voffA); PG8_STAGE_B(PG8_SB(1, 1), cB + hstep + kstep, voffB);
        PG8_WAIT_V(6); PG8_BAR;
    }
    for (;;) {
        const bool has_next = S.next(ui + 1, nxt);
        if constexpr (GA) { if (has_next && wid < 4)
            __builtin_amdgcn_raw_ptr_buffer_load_lds(rsR, (PG8_LAS void*)(lds + GA_LDS_OFF + (ui & 1) * 1024 + wid * 256), 4, tid * 4, nxt.pm * (BM * 4), 0, 0); }
        const char* nA = has_next ? (const char*)g.A + (size_t)nxt.pm * tstepA : cA; const char* nB = has_next ? (const char*)g.Bt + (size_t)nxt.pn * tstep : cB;
        for (int t = 0; t < nt; t += 2) {
            const bool last = (t == nt - 2);
            const char* a1 = cA + (size_t)(t + 1) * kstep;
            const char* a2 = last ? nA : cA + (size_t)(t + 2) * kstep; const char* b2 = last ? nB : cB + (size_t)(t + 2) * kstep;
            const char* a3 = a2 + kstep; const char* b3 = b2 + kstep;
            if (last && has_next) S.a_ready(nxt);
            if constexpr (GA) { if (last) {
#pragma unroll
                for (int h = 0; h < 2; ++h)
#pragma unroll
                    for (int i = 0; i < 2; ++i) vgn[h][i] = has_next ? *(const PG8_LAS unsigned*)(lds + GA_LDS_OFF + (ui & 1) * 1024 + (h * HALF + gR[i]) * 4) + gC[i] : vg[h][i]; } }
            if constexpr (SP2) {
            PG8_LDB(B0, 0, 0); PG8_LDB(B1, 0, 1); PG8_SCHED; PG8_LDA(At, 0, 0); PG8_STA(PG8_SA(1, 1), 1, false, a1 + hstepA);
            PG8_WAIT_V(8); PG8_WAIT_L(0); PG8_BAR; PG8_MMA(0, 0, At, B0); PG8_MMA(0, 1, At, B1); PG8_BAR; PG8_SCHED;
            PG8_LDA(At, 0, 1); PG8_STAGE_B(PG8_SB(0, 0), b2, voffB); PG8_STAGE_B(PG8_SB(0, 1), b2 + hstep, voffB); PG8_STA(PG8_SA(0, 0), 0, last, a2);
            PG8_WAIT_V(8); PG8_WAIT_L(0); PG8_BAR; PG8_MMA(1, 0, At, B0); PG8_MMA(1, 1, At, B1); PG8_BAR; PG8_SCHED;
            PG8_LDB(B0, 1, 0); PG8_LDB(B1, 1, 1); PG8_SCHED; PG8_LDA(At, 1, 0); PG8_STA(PG8_SA(0, 1), 1, last, a2 + hstepA);
            PG8_WAIT_V(8); PG8_WAIT_L(0); PG8_BAR; PG8_MMA(0, 0, At, B0); PG8_MMA(0, 1, At, B1); PG8_BAR; PG8_SCHED;
            PG8_LDA(At, 1, 1); PG8_STAGE_B(PG8_SB(1, 0), b3, voffB); PG8_STAGE_B(PG8_SB(1, 1), b3 + hstep, voffB); PG8_STA(PG8_SA(1, 0), 0, last, a3);
            PG8_WAIT_V(8); PG8_WAIT_L(0); PG8_BAR; PG8_MMA(1, 0, At, B0); PG8_MMA(1, 1, At, B1); PG8_BAR; PG8_SCHED;
            } else {
            PG8_LDB(B0, 0, 0); PG8_SCHED; PG8_LDA(At, 0, 0); PG8_STAGE_A(PG8_SA(1, 1), a1 + hstep, voffA);
            PG8_WAIT_L(8); PG8_BAR; PG8_WAIT_L(0); PG8_MMA(0, 0, At, B0); PG8_BAR; PG8_SCHED;
            PG8_LDB(B1, 0, 1); PG8_STAGE_B(PG8_SB(0, 0), b2, voffB);
            PG8_BAR; PG8_WAIT_L(0); PG8_MMA(0, 1, At, B1); PG8_BAR;
            PG8_LDA(At, 0, 1); PG8_STAGE_A(PG8_SA(0, 0), a2, voffA);
            PG8_BAR; PG8_WAIT_L(0); PG8_MMA(1, 0, At, B0); PG8_BAR; PG8_SCHED;
            PG8_STAGE_B(PG8_SB(0, 1), b2 + hstep, voffB);
            PG8_WAIT_V(6); PG8_BAR; PG8_MMA(1, 1, At, B1); PG8_BAR;
            PG8_LDB(B0, 1, 0); PG8_SCHED; PG8_LDA(At, 1, 0); PG8_STAGE_A(PG8_SA(0, 1), a2 + hstep, voffA);
            PG8_WAIT_L(8); PG8_BAR; PG8_WAIT_L(0); PG8_MMA(0, 0, At, B0); PG8_BAR; PG8_SCHED;
            PG8_LDB(B1, 1, 1); PG8_STAGE_B(PG8_SB(1, 0), b3, voffB);
            PG8_BAR; PG8_WAIT_L(0); PG8_MMA(0, 1, At, B1); PG8_BAR;
            PG8_LDA(At, 1, 1); PG8_STAGE_A(PG8_SA(1, 0), a3, voffA);
            PG8_BAR; PG8_WAIT_L(0); PG8_MMA(1, 0, At, B0); PG8_BAR; PG8_SCHED;
            PG8_STAGE_B(PG8_SB(1, 1), b3 + hstep, voffB);
            PG8_WAIT_V(6); PG8_BAR; PG8_MMA(1, 1, At, B1); PG8_BAR;
            }
        }
        if constexpr (F8) asm volatile("s_nop 15\n\ts_nop 15" ::: "memory");
        if constexpr (ALIGN_EPI) { if (wr == 0) PG8_BAR; }
        if constexpr (!Epi::AFTER_DRAIN) { E(acc, cur, wr, wc, fr, fq); S.done(cur); }
        if (!has_next) break;
#pragma unroll
        for (int a = 0; a < 2; ++a)
#pragma unroll
            for (int b = 0; b < 2; ++b)
#pragma unroll
                for (int m = 0; m < 4; ++m)
#pragma unroll
                    for (int n = 0; n < 2; ++n) acc[a][b][m][n] = (f32x4){0.f, 0.f, 0.f, 0.f};
        cur = nxt; cA = nA; cB = nB; ++ui;
        if constexpr (GA) {
#pragma unroll
            for (int h = 0; h < 2; ++h)
#pragma unroll
                for (int i = 0; i < 2; ++i) vg[h][i] = vgn[h][i]; }
        if constexpr (ALIGN_EPI) { if (wr == 1) PG8_BAR; }
    }
    PG8_WAIT_V(0);
    if constexpr (!ALIGN_EPI) { if (wr == 0) PG8_BAR; }
    PG8_BAR;
    if constexpr (Epi::AFTER_DRAIN) { E.fused(acc, cur, wr, wc, fr, fq, lds, wid, lane); S.done(cur); }
#undef PG8_SA
#undef PG8_SB
#undef PG8_STAGE_X
#undef PG8_STAGE_A
#undef PG8_STA
#undef PG8_STAGE_B
#undef PG8_LDA
#undef PG8_LDB
#undef PG8_MMA
#undef PG8_WAIT_V
#undef PG8_WAIT_L
#undef PG8_BAR
#undef PG8_SCHED
}
}

#define GAS __attribute__((address_space(1)))
#define LAS __attribute__((address_space(3)))
typedef unsigned short bf16_t;
typedef float f32x4 __attribute__((ext_vector_type(4)));
typedef float f32x2 __attribute__((ext_vector_type(2)));
typedef float f32x16 __attribute__((ext_vector_type(16)));
typedef unsigned u32x4 __attribute__((ext_vector_type(4)));
typedef unsigned u32x2 __attribute__((ext_vector_type(2)));
typedef short bf16x8 __attribute__((ext_vector_type(8)));
typedef short s16x4 __attribute__((ext_vector_type(4)));
typedef GAS unsigned gu32;
#define RLX_AGENT __ATOMIC_RELAXED, __HIP_MEMORY_SCOPE_AGENT
#define LDS_WAIT() asm volatile("s_waitcnt lgkmcnt(0)" ::: "memory")
#define VM_WAIT() asm volatile("s_waitcnt vmcnt(0)" ::: "memory")
__device__ __forceinline__ unsigned cvtpk(float lo, float hi) { unsigned r; asm volatile("v_cvt_pk_bf16_f32 %0, %1, %2" : "=v"(r) : "v"(lo), "v"(hi)); return r; }
__device__ __forceinline__ float bf_lo(unsigned w) { return __uint_as_float(w << 16); }
typedef __fp16 f16x2_t __attribute__((__vector_size__(2 * sizeof(__fp16))));
__device__ __forceinline__ unsigned pkh(float lo, float hi) { return __builtin_bit_cast(unsigned, __builtin_amdgcn_cvt_pkrtz(lo, hi)); }
__device__ __forceinline__ float h_lo(unsigned w) { return (float)__builtin_bit_cast(f16x2_t, w)[0]; }
__device__ __forceinline__ float h_hi(unsigned w) { return (float)__builtin_bit_cast(f16x2_t, w)[1]; }
__device__ __forceinline__ float bf_hi(unsigned w) { return __uint_as_float(w & 0xffff0000u); }
__device__ __forceinline__ float shx(float v, int mask, int lane) { return __int_as_float(__builtin_amdgcn_ds_bpermute((lane ^ mask) << 2, __float_as_int(v))); }
__device__ __forceinline__ int shup_i(int v, int o, int lane) { return __builtin_amdgcn_ds_bpermute(((lane - o) & 63) << 2, v); }
__device__ __forceinline__ float wave_sum(float v, int lane) {
#pragma unroll
    for (int o = 1; o < 64; o <<= 1) v += shx(v, o, lane);
    return v;
}

#ifndef REP_MASK
#define REP_MASK 0
#endif
#ifndef REP_N
#define REP_N 1
#endif
#define PH_REP(k) (1 + REP_N * (((REP_MASK) >> (k)) & 1))
template <int CTRL> __device__ __forceinline__ float dpp_mov(float v) { return __int_as_float(__builtin_amdgcn_update_dpp(0, __float_as_int(v), CTRL, 0xF, 0xF, true)); }
__device__ __forceinline__ float sum8_dpp(float v) { v += dpp_mov<0xB1>(v); v += dpp_mov<0x4E>(v); v += dpp_mov<0x141>(v); return v; }
__device__ __forceinline__ float swap16_add(float a, float b) { auto r = __builtin_amdgcn_permlane16_swap(__float_as_uint(a), __float_as_uint(b), false, false); return __uint_as_float(r[0]) + __uint_as_float(r[1]); }
__device__ __forceinline__ float swap32_add(float a, float b) { auto r = __builtin_amdgcn_permlane32_swap(__float_as_uint(a), __float_as_uint(b), false, false); return __uint_as_float(r[0]) + __uint_as_float(r[1]); }
__device__ __forceinline__ float wave_sum_v(float v) { v = sum8_dpp(v); v += dpp_mov<0x128>(v); v = swap16_add(v, v); return swap32_add(v, v); }
constexpr int DM = 2048, NB = 8, SEQ = 4096, T = NB * SEQ, HD = 128;
constexpr int AB_IN = 6144, C_IN = 3072, NE = 16, EH = 2048, CAP = 512, NSLOT = NB * NE * CAP;
constexpr float ALPHA = 1.4142135623730951f, LN_EPS = 1e-5f;
constexpr float SCALE = 0.088388347648318440f;
constexpr float LAM_INIT0 = 0.2f;
constexpr float WDN_SCALE = 128.f, HID_SCALE = 8.f, WGU_SCALE = 64.f, H2_SCALE = 4.f, YD_SCALE = 16.f;
constexpr float HIN1_SCALE = 16.f, WIN1_SCALE = 512.f;
constexpr float YO1_SCALE = 256.f;
constexpr float YATT_SCALE = 32.f, WOUT_SCALE = 128.f;

constexpr size_t MiB = 1u << 20;
constexpr size_t WS_CTL = 0, CTL_ZERO_BYTES = 1 * MiB;
constexpr size_t WS_MOD = 1 * MiB;
constexpr size_t WS_AFF = 2 * MiB;
constexpr size_t WS_IDX = 4 * MiB;
constexpr size_t WS_INVC = 5 * MiB;
constexpr size_t WS_INVG = 7 * MiB;
constexpr size_t WS_LSE = 9 * MiB;
constexpr size_t WS_WIN0 = 12 * MiB, WS_WIN1 = 36 * MiB, WS_WOUT0 = 48 * MiB, WS_WOUT1 = 56 * MiB;
constexpr size_t WS_WGU = 64 * MiB;
constexpr size_t WS_WDN = 320 * MiB;
constexpr size_t WS_HB = 448 * MiB;
constexpr size_t WS_R1 = 576 * MiB;
constexpr size_t WS_R2 = 960 * MiB;
constexpr size_t WS_R3 = 1344 * MiB;
constexpr size_t WS_X1 = 1600 * MiB;
constexpr size_t WS_END = 1856 * MiB;
constexpr int CW_BAR = 4096;
constexpr int CW_NRM = 8192;

constexpr int RING_BYTES = 131072;
constexpr int MISC_OFF = RING_BYTES + 320;
constexpr int LDS_BYTES = 147456;

#define XB_TMO      128
#define XB_XCNT(j)  (256  + 64 * (j))
#define XB_XSUB(j)  (1280 + 64 * (j))
#define XB_XGEN(j)  (2304 + 64 * (j))
#define XB_TOP      3328
#define XB_TOPGEN   3392
#define XCD_BAR_WORDS 3456
#define XB_SPIN_CAP (1u << 18)

__device__ __forceinline__ unsigned xb_ld(unsigned* p)              { return __hip_atomic_load(p, __ATOMIC_RELAXED, __HIP_MEMORY_SCOPE_AGENT); }
__device__ __forceinline__ unsigned xb_add(unsigned* p, unsigned v) { return __hip_atomic_fetch_add(p, v, __ATOMIC_RELAXED, __HIP_MEMORY_SCOPE_AGENT); }
__device__ __forceinline__ unsigned xb_xcc_id() { return (unsigned)__builtin_amdgcn_s_getreg((3 << 11) | 20) & 0xFu; }
#define XB_SPIN(cond, bar) do { unsigned _sp = 0; while (cond) { __builtin_amdgcn_s_sleep(1); \
    if ((++_sp & 255u) == 0u) { if (xb_ld(&(bar)[XB_TMO])) break; if (_sp > XB_SPIN_CAP) { atomicAdd(&(bar)[XB_TMO], 1u); break; } } } } while (0)

struct XcdBarrier {
    unsigned* bar; unsigned x;
    volatile LAS unsigned* st;
};

__device__ __forceinline__ XcdBarrier xcd_barrier_post(unsigned* bar, volatile LAS unsigned* st) {
    XcdBarrier b; b.bar = bar; b.x = xb_xcc_id(); b.st = st;
    if (threadIdx.x == 0) (void)xb_add(&bar[XB_XCNT(b.x)], 1u);
    return b;
}
__device__ __forceinline__ void xcd_barrier_complete(unsigned* bar, unsigned x, unsigned& nloc, unsigned& nx) {
    const unsigned G = gridDim.x * gridDim.y * gridDim.z;
    unsigned sum, cnt, mine, sp = 0u;
    for (;;) {
        sum = 0u; cnt = 0u; mine = 0u;
#pragma unroll
        for (unsigned j = 0; j < 16; ++j) { const unsigned c = xb_ld(&bar[XB_XCNT(j)]); sum += c; cnt += (c > 0u) ? 1u : 0u; mine = (j == x) ? c : mine; }
        if (sum == G) break;
        __builtin_amdgcn_s_sleep(1);
        if ((++sp & 255u) == 0u) { if (xb_ld(&bar[XB_TMO])) break; if (sp > XB_SPIN_CAP) { atomicAdd(&bar[XB_TMO], 1u); break; } }
    }
    nloc = mine > 0u ? mine : 1u; nx = cnt > 0u ? cnt : 1u;
}

__device__ __forceinline__ void xcd_barrier(const XcdBarrier& b, const bool leader  ) {
    asm volatile("s_waitcnt vmcnt(0)" ::: "memory");
    __syncthreads();
    if (leader) {
        unsigned* bar = b.bar;
        __builtin_amdgcn_s_waitcnt(0);
        unsigned nloc = b.st[0], nx = b.st[1];
        if (nloc == 0u) { xcd_barrier_complete(bar, b.x, nloc, nx); b.st[0] = nloc; b.st[1] = nx; }
        const unsigned old = xb_add(&bar[XB_XSUB(b.x)], 1u);
        const unsigned gen = old / nloc;
        if (old + 1u == (gen + 1u) * nloc) {
            __builtin_amdgcn_fence(__ATOMIC_RELEASE, "agent");
            asm volatile("s_waitcnt vmcnt(0)" ::: "memory");
            const unsigned og = xb_add(&bar[XB_TOP], 1u);
            const unsigned tg = og / nx;
            if (og + 1u == (tg + 1u) * nx) xb_add(&bar[XB_TOPGEN], 1u);
            else XB_SPIN(xb_ld(&bar[XB_TOPGEN]) == tg, bar);
            __builtin_amdgcn_fence(__ATOMIC_ACQUIRE, "agent");
            xb_add(&bar[XB_XGEN(b.x)], 1u);
            asm volatile("s_waitcnt vmcnt(0)" ::: "memory");
        } else {
            XB_SPIN(xb_ld(&bar[XB_XGEN(b.x)]) == gen, bar);
            __builtin_amdgcn_fence(__ATOMIC_ACQUIRE, "agent");
            asm volatile("s_waitcnt vmcnt(0)" ::: "memory");
        }
    }
    __syncthreads();
}

namespace att {
constexpr int KVBLK = 64;
constexpr int SHM_V = KVBLK * 128 * 2, SHM_K = KVBLK * 128 * 2, SHM_ATTN = 3 * (SHM_V + SHM_K) + 8 * 64 * 4;
constexpr float THR = 8.f;
#define KSWZ(row, colB) ((row) * 256 + ((colB) ^ (((row) & 7) << 4)))
#define SBAR() __builtin_amdgcn_sched_barrier(0)
__device__ __forceinline__ int crow(int r, int hi) { return (r & 3) + 8 * (r >> 2) + 4 * hi; }
constexpr float THR2 = 8.f * 1.4426950408889634f;
__device__ __forceinline__ void partialSM(f32x16& p0, f32x16& p1, float& m_run, float& alpha) {
  float pmax = fmaxf(fmaxf(p0[0], p0[1]), p0[2]);
#pragma unroll
  for (int r = 3; r < 15; r += 2) pmax = fmaxf(fmaxf(pmax, p0[r]), p0[r + 1]);
  pmax = fmaxf(fmaxf(pmax, p0[15]), p1[0]);
#pragma unroll
  for (int r = 1; r < 15; r += 2) pmax = fmaxf(fmaxf(pmax, p1[r]), p1[r + 1]);
  pmax = fmaxf(pmax, p1[15]);
  { auto rr = __builtin_amdgcn_permlane32_swap(__float_as_uint(pmax), __float_as_uint(pmax), false, false);
    pmax = fmaxf(__uint_as_float(rr[0]), __uint_as_float(rr[1])); }
  if (__builtin_expect(__all(pmax <= THR2), 1)) { alpha = 1.f; }
  else { const float d = fmaxf(pmax, 0.f); alpha = __builtin_amdgcn_exp2f(-d); m_run += d;
#pragma unroll
    for (int r = 0; r < 16; ++r) { p0[r] -= d; p1[r] -= d; } }
#pragma unroll
  for (int r = 0; r < 16; ++r) p0[r] = __builtin_amdgcn_exp2f(p0[r]);
}
__device__ __forceinline__ void finishSM(f32x16& p0, f32x16& p1, float alpha, float& l_reg, bf16x8& pa0, bf16x8& pa1, bf16x8& pa2, bf16x8& pa3) {
#pragma unroll
  for (int r = 0; r < 16; ++r) p1[r] = __builtin_amdgcn_exp2f(p1[r]);
  float ps = 0;
#pragma unroll
  for (int r = 0; r < 16; ++r) ps += p0[r];
#pragma unroll
  for (int r = 0; r < 16; ++r) ps += p1[r];
  { auto rr = __builtin_amdgcn_permlane32_swap(__float_as_uint(ps), __float_as_uint(ps), false, false);
    ps = __uint_as_float(rr[0]) + __uint_as_float(rr[1]); }
  l_reg = l_reg * alpha + ps;
#define PK4(P, BASE, OUT) do { unsigned a0 = cvtpk(P[BASE + 0], P[BASE + 1]), a1 = cvtpk(P[BASE + 2], P[BASE + 3]);   \
    unsigned b0 = cvtpk(P[BASE + 4], P[BASE + 5]), b1 = cvtpk(P[BASE + 6], P[BASE + 7]);                              \
    auto r0 = __builtin_amdgcn_permlane32_swap(a0, b0, false, false); auto r1 = __builtin_amdgcn_permlane32_swap(a1, b1, false, false); \
    u32x4 w = {r0[0], r1[0], r0[1], r1[1]}; OUT = __builtin_bit_cast(bf16x8, w); } while (0)
  PK4(p0, 0, pa0); PK4(p0, 8, pa1); PK4(p1, 0, pa2); PK4(p1, 8, pa3);
#undef PK4
}
template <bool BANDED>
__device__ __forceinline__ void qkt(f32x16& p0, f32x16& p1, const LAS char* Ks, const bf16x8* qr, int r32, int hi, float base, float nsl2, float radius, float m_run, int side) {
  if (!BANDED && side != 0) {
    const float sa = nsl2 * (float)side, t = fmaf(sa, base, -m_run), na = -sa;
#pragma unroll
    for (int r = 0; r < 16; ++r) { const float c = (float)((r & 3) + 8 * (r >> 2)); p0[r] = fmaf(na, c, t); p1[r] = fmaf(na, c + 32.f, t); }
  } else {
#pragma unroll
    for (int r = 0; r < 16; ++r) { const float c = (float)((r & 3) + 8 * (r >> 2));
      const float a0 = __builtin_fabsf(base - c), a1 = __builtin_fabsf(base - (c + 32.f));
      float v0 = fmaf(a0, nsl2, -m_run), v1 = fmaf(a1, nsl2, -m_run);
      if (BANDED) { v0 = a0 > radius ? -INFINITY : v0; v1 = a1 > radius ? -INFINITY : v1; }
      p0[r] = v0; p1[r] = v1; }
  }
#pragma unroll
  for (int d0 = 0; d0 < 8; ++d0) { const int cb = (d0 * 16 + hi * 8) * 2;
    const bf16x8 b0 = *(const LAS bf16x8*)(Ks + KSWZ(r32, cb));
    const bf16x8 b1 = *(const LAS bf16x8*)(Ks + KSWZ(32 + r32, cb));
    p0 = __builtin_amdgcn_mfma_f32_32x32x16_bf16(b0, qr[d0], p0, 0, 0, 0);
    p1 = __builtin_amdgcn_mfma_f32_32x32x16_bf16(b1, qr[d0], p1, 0, 0, 0); }
}
__device__ __forceinline__ int v_st(int k, int c) { const int kk = (k & ~0xC) | ((k & 4) << 1) | ((k & 8) >> 1); return ((kk >> 3) * 4 + (c >> 5)) * 512 + ((kk & 7) * 32 + (c & 31)) * 2; }
__device__ __forceinline__ int v_rd_base(int lane) { return ((lane & 3) << 3) | (((lane >> 2) & 3) << 6) | (((lane >> 4) & 1) << 5) | (((lane >> 5) & 1) << 8); }
constexpr int v_rd_off(int d0, int ks, int half) { return d0 * 512 + ks * 4096 + half * 2048; }
template <int OFF> __device__ __forceinline__ s16x4 tr_read(int vb) {
  s16x4 r; asm volatile("ds_read_b64_tr_b16 %0, %1 offset:%2" : "=&v"(r) : "v"(vb), "i"(OFF) : "memory"); return r;
}
template <int D0> __device__ __forceinline__ void pv_one(f32x16& od, int vb, bf16x8 pa0, bf16x8 pa1, bf16x8 pa2, bf16x8 pa3) {
  const s16x4 l0 = tr_read<v_rd_off(D0, 0, 0)>(vb), h0 = tr_read<v_rd_off(D0, 0, 1)>(vb), l1 = tr_read<v_rd_off(D0, 1, 0)>(vb), h1 = tr_read<v_rd_off(D0, 1, 1)>(vb);
  const s16x4 l2 = tr_read<v_rd_off(D0, 2, 0)>(vb), h2 = tr_read<v_rd_off(D0, 2, 1)>(vb), l3 = tr_read<v_rd_off(D0, 3, 0)>(vb), h3 = tr_read<v_rd_off(D0, 3, 1)>(vb);
  asm volatile("s_waitcnt lgkmcnt(0)" ::: "memory"); SBAR();
#define PK(L, H) (bf16x8){L[0], L[1], L[2], L[3], H[0], H[1], H[2], H[3]}
  od = __builtin_amdgcn_mfma_f32_32x32x16_bf16(pa0, PK(l0, h0), od, 0, 0, 0);
  od = __builtin_amdgcn_mfma_f32_32x32x16_bf16(pa1, PK(l1, h1), od, 0, 0, 0);
  od = __builtin_amdgcn_mfma_f32_32x32x16_bf16(pa2, PK(l2, h2), od, 0, 0, 0);
  od = __builtin_amdgcn_mfma_f32_32x32x16_bf16(pa3, PK(l3, h3), od, 0, 0, 0);
#undef PK
}
__device__ __forceinline__ void pv_d0(f32x16* o, int vb, bf16x8 pa0, bf16x8 pa1, bf16x8 pa2, bf16x8 pa3) {
  pv_one<0>(o[0], vb, pa0, pa1, pa2, pa3); pv_one<1>(o[1], vb, pa0, pa1, pa2, pa3); pv_one<2>(o[2], vb, pa0, pa1, pa2, pa3); pv_one<3>(o[3], vb, pa0, pa1, pa2, pa3);
}

template <bool BANDED>
__device__ __forceinline__ void attn_unit(const bf16_t* __restrict__ Qb, int ldq, const bf16_t* __restrict__ Kt, const bf16_t* __restrict__ Vt, int ldk,
                                          bf16_t* __restrict__ Ob, int ldo, float* __restrict__ Lb, int ldl,
                                          int qrel, int NT, float nsl2, float radius, float sink2, LAS char* lds, const int wave0, const bool o8 = false) {
  int tid = wave0 * 64 + ({ int l_; asm volatile("v_mbcnt_lo_u32_b32 %0, -1, 0\n\tv_mbcnt_hi_u32_b32 %0, -1, %0" : "=v"(l_)); l_; });
  const int wid = tid >> 6, lane = tid & 63, r32 = lane & 31, hi = lane >> 5;
  const int wu = __builtin_amdgcn_readfirstlane(wid);
  LAS float* ws = (LAS float*)(lds + 3 * 32768) + wid * 64; LAS float* li_l = ws; LAS float* al_l = ws + 32;
  __syncthreads();
  const __amdgpu_buffer_rsrc_t krs = __builtin_amdgcn_make_buffer_rsrc((void*)Kt, 0, 0x7FFFFFFF, 0x00020000), vrs = __builtin_amdgcn_make_buffer_rsrc((void*)Vt, 0, 0x7FFFFFFF, 0x00020000);
  int koffD[2], voffD[2];
#pragma unroll
  for (int i = 0; i < 2; ++i) { const int row = (i * 8 + wid) * 4 + (lane >> 4), cp = lane & 15; koffD[i] = (row * ldk) * 2 + ((cp ^ (row & 7)) << 4);
    const int s_ = (i * 8 + wid) * 2 + (lane >> 5), kk = (s_ >> 2) * 8 + ((lane & 31) >> 2), c = (s_ & 3) * 32 + (lane & 3) * 8, k = (kk & ~0xC) | ((kk & 4) << 1) | ((kk & 8) >> 1);
    voffD[i] = (k * ldk + c) * 2; }
  const int tstep = 128 * ldk;
#define DISSUE(j) do { const int o_ = (j) * tstep; LAS char* sb_ = lds + ((j) % 3) * 32768 + wu * 1024; \
    __builtin_amdgcn_raw_ptr_buffer_load_lds(vrs, (LAS void*)(sb_), 16, voffD[0], o_, 0, 0); __builtin_amdgcn_raw_ptr_buffer_load_lds(vrs, (LAS void*)(sb_ + 8192), 16, voffD[1], o_, 0, 0); \
    __builtin_amdgcn_raw_ptr_buffer_load_lds(krs, (LAS void*)(sb_ + 16384), 16, koffD[0], o_, 0, 0); __builtin_amdgcn_raw_ptr_buffer_load_lds(krs, (LAS void*)(sb_ + 16384 + 8192), 16, koffD[1], o_, 0, 0); } while (0)
#define BAR() asm volatile("s_waitcnt lgkmcnt(0)\n\ts_barrier" ::: "memory")
#define WAITBAR(more) do { if (more) asm volatile("s_waitcnt vmcnt(4) lgkmcnt(0)\n\ts_barrier" ::: "memory"); else asm volatile("s_waitcnt vmcnt(0) lgkmcnt(0)\n\ts_barrier" ::: "memory"); } while (0)
  DISSUE(0); DISSUE(1);
  float m_reg = 0.f, l_reg = 0; f32x16 o[4] = {}; bf16x8 qr[8];
  { const unsigned qoff = (unsigned)((wid * 32 + r32) * ldq + hi * 8) * 2u;
#pragma unroll
    for (int d0 = 0; d0 < 8; ++d0) qr[d0] = *(const bf16x8*)((const char*)Qb + (qoff + d0 * 32)); }
  const int vb0 = (int)(unsigned)(uintptr_t)lds + v_rd_base(lane);
  const float qb_f = (float)(qrel + wid * 32 + r32 - 4 * hi);
#define RESC(a) do { if (__any((a) < 1.f)) { if (hi == 0) al_l[r32] = (a); asm volatile("s_waitcnt lgkmcnt(0)" ::: "memory"); \
    _Pragma("unroll") for (int d = 0; d < 4; ++d) _Pragma("unroll") for (int r = 0; r < 16; ++r) o[d][r] *= al_l[crow(r, hi)]; } } while (0)
#define SLOT(j) ({ int so_ = ((j) % 3) * 32768; asm volatile("" : "+s"(so_)); so_; })
#define SIDE(j) ((64 * (j) + 63 <= qw_) ? 1 : ((64 * (j) >= qw_ + 31) ? -1 : 0))
#define QKT(P0, P1, j) qkt<BANDED>(P0, P1, lds + SLOT(j) + 16384, qr, r32, hi, qb_f - (float)(64 * (j)), nsl2, radius, m_reg, SIDE(j))
#define PV(j) pv_d0(o, vb0 + SLOT(j), pa0, pa1, pa2, pa3)
  f32x16 pA0, pA1, pB0, pB1; float alA, alB; bf16x8 pa0, pa1, pa2, pa3;
  const int qw_ = __builtin_amdgcn_readfirstlane(qrel + 32 * wid), ri_ = (int)radius;
#define NEED(j) (!BANDED || ((64 * (j) + 63 >= qw_ - ri_) && (64 * (j) <= qw_ + 31 + ri_)))
#define QKTN(P0, P1, j, need) do { if (need) QKT(P0, P1, j); } while (0)
#define PSM(P0, P1, AL, need) do { if (need) partialSM(P0, P1, m_reg, AL); else AL = 1.f; } while (0)
#define FSM(P0, P1, AL, need) do { if (need) finishSM(P0, P1, AL, l_reg, pa0, pa1, pa2, pa3); } while (0)
  asm volatile("s_waitcnt vmcnt(0) lgkmcnt(0)\n\ts_barrier" ::: "memory");
  { const bool n0 = NEED(0); QKTN(pA0, pA1, 0, n0); PSM(pA0, pA1, alA, n0); }
  if (2 < NT) DISSUE(2);
  for (int j = 1; j + 1 < NT; j += 2) {
    const bool nP = NEED(j - 1), nC = NEED(j), nN = NEED(j + 1);
    SBAR(); QKTN(pB0, pB1, j, nC);
    FSM(pA0, pA1, alA, nP); SBAR();
    if (nP) PV(j - 1); PSM(pB0, pB1, alB, nC);
    BAR(); if (j + 2 < NT) DISSUE(j + 2);
    if (nC) RESC(alB); WAITBAR(j + 2 < NT);
    SBAR(); QKTN(pA0, pA1, j + 1, nN);
    FSM(pB0, pB1, alB, nC); SBAR();
    if (nC) PV(j); PSM(pA0, pA1, alA, nN);
    BAR(); if (j + 3 < NT) DISSUE(j + 3);
    if (nN) RESC(alA); WAITBAR(j + 3 < NT);
  }
  { const bool nP = NEED(NT - 2), nC = NEED(NT - 1);
    SBAR(); QKTN(pB0, pB1, NT - 1, nC);
    FSM(pA0, pA1, alA, nP); SBAR();
    if (nP) PV(NT - 2); PSM(pB0, pB1, alB, nC);
    if (nC) { RESC(alB);
      finishSM(pB0, pB1, alB, l_reg, pa0, pa1, pa2, pa3); SBAR();
      PV(NT - 1); } }
#undef PSM
#undef FSM
#undef QKTN
#undef DISSUE
#undef BAR
#undef WAITBAR
#undef PV
#undef SLOT
#undef SIDE
  { const float mf = fmaxf(m_reg, sink2); const float a = __builtin_amdgcn_exp2f(m_reg - mf); const float lnew = l_reg * a + __builtin_amdgcn_exp2f(sink2 - mf);
    if (hi == 0) li_l[r32] = a / lnew;
    if (Lb != nullptr && hi == 0) Lb[(wid * 32 + r32) * ldl] = (m_reg + __log2f(l_reg)) * 0.69314718055994531f; }
  asm volatile("s_waitcnt lgkmcnt(0)" ::: "memory");
  float rli[16];
#pragma unroll
  for (int r = 0; r < 16; ++r) rli[r] = li_l[crow(r, hi)];
  __syncthreads();
  if (o8) { LAS char* st = lds + wid * 8448;
#pragma unroll
    for (int r = 0; r < 16; ++r) { const int orow = crow(r, hi); const float sc = rli[r] * YATT_SCALE;
#pragma unroll
      for (int d0 = 0; d0 < 4; ++d0) { const float x = __builtin_fminf(__builtin_fmaxf(o[d0][r] * sc, -448.f), 448.f);
        *(LAS unsigned char*)(st + orow * 136 + d0 * 32 + r32) = (unsigned char)(__builtin_amdgcn_cvt_pk_fp8_f32(x, 0.f, 0, false) & 0xff); } }
    asm volatile("s_waitcnt lgkmcnt(0)" ::: "memory");
    const int rr = lane >> 3, ch = lane & 7;
#pragma unroll
    for (int t = 0; t < 4; ++t) { const int row = 8 * t + rr; const u32x2 lo = *(const LAS u32x2*)(st + row * 136 + ch * 16), hi2 = *(const LAS u32x2*)(st + row * 136 + ch * 16 + 8);
      *(u32x4*)((char*)Ob + ((size_t)(unsigned)((wid * 32 + row) * ldo)) * 2 + ch * 16) = (u32x4){lo.x, lo.y, hi2.x, hi2.y}; } }
  else { LAS char* st = lds + wid * 8448;
#pragma unroll
    for (int r = 0; r < 16; ++r) { const int orow = crow(r, hi);
#pragma unroll
      for (int d0 = 0; d0 < 4; ++d0) *(LAS unsigned short*)(st + orow * 264 + (d0 * 32 + r32) * 2) = (unsigned short)(cvtpk(o[d0][r] * rli[r], 0.f) & 0xffffu); }
    asm volatile("s_waitcnt lgkmcnt(0)" ::: "memory");
    const int rr = lane >> 4, ch = lane & 15;
#pragma unroll
    for (int t = 0; t < 8; ++t) { const int row = 4 * t + rr; const u32x2 lo = *(const LAS u32x2*)(st + row * 264 + ch * 16), hi2 = *(const LAS u32x2*)(st + row * 264 + ch * 16 + 8);
      *(u32x4*)((char*)Ob + ((size_t)(unsigned)((wid * 32 + row) * ldo + ch * 8)) * 2) = (u32x4){lo.x, lo.y, hi2.x, hi2.y}; } }
#undef RESC
#undef QKT
#undef NEED
}

__device__ __forceinline__ void softmax_tile(f32x16& p0, f32x16& p1, float& m_run, float& alpha, float& l_reg, bf16x8& pa0, bf16x8& pa1, bf16x8& pa2, bf16x8& pa3) {
  partialSM(p0, p1, m_run, alpha); finishSM(p0, p1, alpha, l_reg, pa0, pa1, pa2, pa3);
}
__device__ __forceinline__ void attn_unit256(const bf16_t* __restrict__ Qb, int ldq, const bf16_t* __restrict__ Kt, const bf16_t* __restrict__ Vt, int ldk,
                                             bf16_t* __restrict__ Ob, int ldo, int qrel, int NT, float nsl2, LAS char* lds, const int wave0) {
  int tid = wave0 * 64 + ({ int l_; asm volatile("v_mbcnt_lo_u32_b32 %0, -1, 0\n\tv_mbcnt_hi_u32_b32 %0, -1, %0" : "=v"(l_)); l_; });
  const int wid = tid >> 6, lane = tid & 63, r32 = lane & 31, hi = lane >> 5;
  const int wu = __builtin_amdgcn_readfirstlane(wid);
  constexpr int KS = 0, VS = 32768, WSO = 98304;
  LAS float* ws = (LAS float*)(lds + WSO) + wid * 64; LAS float* li_l = ws; LAS float* al_l = ws + 32;
  __syncthreads();
  const __amdgpu_buffer_rsrc_t krs = __builtin_amdgcn_make_buffer_rsrc((void*)Kt, 0, 0x7FFFFFFF, 0x00020000), vrs = __builtin_amdgcn_make_buffer_rsrc((void*)Vt, 0, 0x7FFFFFFF, 0x00020000);
  int koffD[2], voffD[2];
#pragma unroll
  for (int i = 0; i < 2; ++i) { const int row = (i * 8 + wid) * 4 + (lane >> 4), cp = lane & 15; koffD[i] = (row * ldk) * 2 + ((cp ^ (row & 7)) << 4);
    const int s_ = (i * 8 + wid) * 2 + (lane >> 5), kk = (s_ >> 2) * 8 + ((lane & 31) >> 2), c = (s_ & 3) * 32 + (lane & 3) * 8, k = (kk & ~0xC) | ((kk & 4) << 1) | ((kk & 8) >> 1);
    voffD[i] = (k * ldk + c) * 2; }
  const int tstep = 128 * ldk;
#define ISSUEK(j) do { const int o_ = (j) * tstep; LAS char* sb_ = lds + KS + ((j) & 1) * 16384 + wu * 1024; \
    __builtin_amdgcn_raw_ptr_buffer_load_lds(krs, (LAS void*)(sb_), 16, koffD[0], o_, 0, 0); __builtin_amdgcn_raw_ptr_buffer_load_lds(krs, (LAS void*)(sb_ + 8192), 16, koffD[1], o_, 0, 0); } while (0)
#define ISSUEV(j) do { const int o_ = (j) * tstep; LAS char* sb_ = lds + VS + ((j) & 1) * 32768 + wu * 1024; \
    __builtin_amdgcn_raw_ptr_buffer_load_lds(vrs, (LAS void*)(sb_), 16, voffD[0], o_, 0, 0); __builtin_amdgcn_raw_ptr_buffer_load_lds(vrs, (LAS void*)(sb_ + 8192), 16, voffD[1], o_, 0, 0); \
    __builtin_amdgcn_raw_ptr_buffer_load_lds(vrs, (LAS void*)(sb_ + 16384), 16, voffD[0] + 256, o_, 0, 0); __builtin_amdgcn_raw_ptr_buffer_load_lds(vrs, (LAS void*)(sb_ + 16384 + 8192), 16, voffD[1] + 256, o_, 0, 0); } while (0)
  ISSUEK(0); ISSUEV(0);
  float m_reg = 0.f, l_reg = 0.f, al = 1.f; f32x16 o[8] = {}; bf16x8 qr[8];
  { const unsigned qoff = (unsigned)((wid * 32 + r32) * ldq + hi * 8) * 2u;
#pragma unroll
    for (int d0 = 0; d0 < 8; ++d0) qr[d0] = *(const bf16x8*)((const char*)Qb + (qoff + d0 * 32)); }
  const int vb0 = (int)(unsigned)(uintptr_t)lds + VS + v_rd_base(lane);
  const float qb_f = (float)(qrel + wid * 32 + r32 - 4 * hi);
  const int qw_ = __builtin_amdgcn_readfirstlane(qrel + 32 * wid);
  f32x16 p0, p1; bf16x8 pa0, pa1, pa2, pa3;
#define RESC8(a) do { if (__any((a) < 1.f)) { if (hi == 0) al_l[r32] = (a); asm volatile("s_waitcnt lgkmcnt(0)" ::: "memory"); \
    _Pragma("unroll") for (int d = 0; d < 8; ++d) _Pragma("unroll") for (int r = 0; r < 16; ++r) o[d][r] *= al_l[crow(r, hi)]; } } while (0)
#define OPQ(x) ({ int so_ = __builtin_amdgcn_readfirstlane(x); asm volatile("" : "+s"(so_)); so_; })
#define QKSM(j) do { qkt<false>(p0, p1, lds + KS + OPQ(((j) & 1) * 16384), qr, r32, hi, qb_f - (float)(64 * (j)), nsl2, 0.f, m_reg, ((64 * (j) + 63 <= qw_) ? 1 : ((64 * (j) >= qw_ + 31) ? -1 : 0))); \
    softmax_tile(p0, p1, m_reg, al, l_reg, pa0, pa1, pa2, pa3); } while (0)
#define PV8(j) do { const int vb_ = vb0 + OPQ(((j) & 1) * 32768); RESC8(al); pv_d0(o, vb_, pa0, pa1, pa2, pa3); pv_d0(o + 4, vb_ + 16384, pa0, pa1, pa2, pa3); } while (0)
  asm volatile("s_waitcnt vmcnt(0) lgkmcnt(0)\n\ts_barrier" ::: "memory");
  for (int j = 0; j < NT; ++j) {
    if (j > 0) asm volatile("s_waitcnt vmcnt(0) lgkmcnt(0)\n\ts_barrier" ::: "memory");
    if (j + 1 < NT) { ISSUEK(j + 1); ISSUEV(j + 1); }
    QKSM(j); PV8(j);
  }
  if (hi == 0) li_l[r32] = 1.0f / l_reg;
  asm volatile("s_waitcnt lgkmcnt(0)" ::: "memory");
  float rli[16];
#pragma unroll
  for (int r = 0; r < 16; ++r) rli[r] = li_l[crow(r, hi)];
#pragma unroll
  for (int half = 0; half < 2; ++half) {
    __syncthreads();
    LAS char* st = lds + wid * 8448;
#pragma unroll
    for (int r = 0; r < 16; ++r) { const int orow = crow(r, hi);
#pragma unroll
      for (int d0 = 0; d0 < 4; ++d0) *(LAS unsigned short*)(st + orow * 264 + (d0 * 32 + r32) * 2) = (unsigned short)(cvtpk(o[half * 4 + d0][r] * rli[r], 0.f) & 0xffffu); }
    asm volatile("s_waitcnt lgkmcnt(0)" ::: "memory");
    const int rr = lane >> 4, ch = lane & 15;
#pragma unroll
    for (int t = 0; t < 8; ++t) { const int row = 4 * t + rr; const u32x2 lo = *(const LAS u32x2*)(st + row * 264 + ch * 16), hi2 = *(const LAS u32x2*)(st + row * 264 + ch * 16 + 8);
      *(u32x4*)((char*)Ob + ((size_t)(unsigned)((wid * 32 + row) * ldo + half * 128 + ch * 8)) * 2) = (u32x4){lo.x, lo.y, hi2.x, hi2.y}; }
  }
#undef ISSUEK
#undef ISSUEV
#undef RESC8
#undef OPQ
#undef QKSM
#undef PV8
}
}

struct Args { const float* in[17]; float* out; unsigned char* ws; int ph_lo, ph_hi; };
enum { IN_X = 0, IN_C, IN_ADAW, IN_ADAB, IN_LNG, IN_LNB, IN_ABWIN, IN_ABWOUT, IN_DLAM, IN_SUBLN, IN_CWIN, IN_CWOUT, IN_CSINK, IN_ROUTER, IN_WGATE, IN_WUP, IN_WDOWN };

__device__ __forceinline__ void transpose_item(const float* __restrict__ W, int ldn, int K, int k0, int n0, bf16_t* __restrict__ dst, int drow0, float wscale, LAS float* scr, int lane) {
    f32x4 v[8];
#pragma unroll
    for (int i = 0; i < 8; ++i) v[i] = *(const f32x4*)(W + (size_t)(k0 + 8 * i + (lane >> 3)) * ldn + n0 + 4 * (lane & 7));
#pragma unroll
    for (int i = 0; i < 8; ++i) { LAS float* d = scr + (8 * i + (lane >> 3)) * 33 + 4 * (lane & 7); d[0] = v[i][0] * wscale; d[1] = v[i][1] * wscale; d[2] = v[i][2] * wscale; d[3] = v[i][3] * wscale; }
    LDS_WAIT(); asm volatile("" ::: "memory");
    const int c = lane & 7;
#pragma unroll
    for (int j = 0; j < 4; ++j) { const int n = (lane >> 3) + 8 * j; const LAS float* s = scr + (8 * c) * 33 + n;
        u32x4 o; o.x = cvtpk(s[0 * 33], s[1 * 33]); o.y = cvtpk(s[2 * 33], s[3 * 33]); o.z = cvtpk(s[4 * 33], s[5 * 33]); o.w = cvtpk(s[6 * 33], s[7 * 33]);
        *(u32x4*)(dst + (size_t)(drow0 + n) * K + k0 + 8 * c) = o; }
    LDS_WAIT(); asm volatile("" ::: "memory");
}
__device__ __forceinline__ void transpose_item_f8(const float* __restrict__ W, int ldn, int K, int k0, int n0, unsigned char* __restrict__ dst, int drow0, float wscale, LAS float* scr, int lane) {
    f32x4 v[8];
#pragma unroll
    for (int i = 0; i < 8; ++i) v[i] = *(const f32x4*)(W + (size_t)(k0 + 8 * i + (lane >> 3)) * ldn + n0 + 4 * (lane & 7));
#pragma unroll
    for (int i = 0; i < 8; ++i) { LAS float* d = scr + (8 * i + (lane >> 3)) * 33 + 4 * (lane & 7); d[0] = v[i][0] * wscale; d[1] = v[i][1] * wscale; d[2] = v[i][2] * wscale; d[3] = v[i][3] * wscale; }
    LDS_WAIT(); asm volatile("" ::: "memory");
    const int c = lane & 3;
#pragma unroll
    for (int j = 0; j < 2; ++j) { const int n = (lane >> 2) + 16 * j; const LAS float* s = scr + (16 * c) * 33 + n;
        int w[4];
#pragma unroll
        for (int q = 0; q < 4; ++q) { w[q] = __builtin_amdgcn_cvt_pk_fp8_f32(s[(4 * q + 0) * 33], s[(4 * q + 1) * 33], 0, false); w[q] = __builtin_amdgcn_cvt_pk_fp8_f32(s[(4 * q + 2) * 33], s[(4 * q + 3) * 33], w[q], true); }
        *(u32x4*)(dst + (size_t)(drow0 + n) * K + k0 + 16 * c) = (u32x4){(unsigned)w[0], (unsigned)w[1], (unsigned)w[2], (unsigned)w[3]}; }
    LDS_WAIT(); asm volatile("" ::: "memory");
}
constexpr float QSCALE = SCALE * 1.4426950408889634f;
__device__ __forceinline__ void conv_plain_item(const float* W, int K, int N, bf16_t* dst, int item, int qmode, LAS float* scr, int lane) {
    const int nblk = N / 32, kb = item / nblk, nb = item % nblk, n0 = 32 * nb;
    const bool isq = qmode == 1 ? (n0 < 1024 || (n0 >= 3072 && n0 < 4096)) : (qmode == 2 ? n0 < 2048 : false);
    transpose_item(W, N, K, 64 * kb, n0, dst, n0, isq ? QSCALE : 1.0f, scr, lane);
}
__device__ __forceinline__ void conv_ffn_item(const Args& a, int l, int item, LAS float* scr, int lane) {
    const int m = item >> 11, r = item & 2047, kind = m >> 4, e = m & 15, kb = r >> 6, nb = r & 63, n0 = 32 * nb;
    const size_t eoff = ((size_t)l * NE + e) * (size_t)DM * EH;
    if (kind == 2) { transpose_item_f8(a.in[IN_WDOWN] + eoff, DM, EH, 64 * kb, n0, (unsigned char*)(a.ws + WS_WDN) + (size_t)e * DM * EH, n0, WDN_SCALE, scr, lane); }
    else { const float* W = (kind == 0 ? a.in[IN_WGATE] : a.in[IN_WUP]) + eoff;
           const int drow = (n0 >> 7) * 256 + (n0 & 127) + (kind == 1 ? 128 : 0);
           transpose_item_f8(W, EH, DM, 64 * kb, n0, (unsigned char*)(a.ws + WS_WGU) + (size_t)e * 4096 * DM, drow, WGU_SCALE, scr, lane); }
}

__device__ __forceinline__ void phase_prologue(const Args& a, LAS unsigned char* lds, int tid, int lane, int wave, int vcu, int G, int bx) {
    float* MOD = (float*)(a.ws + WS_MOD);
    for (int it = bx; it < 192; it += G) {
        const int l = it / 96, n0 = (it % 96) * 128;
        LAS float* cs = (LAS float*)lds;
        for (int i = tid; i < NB * DM; i += 512) { const int b = i >> 11, k = i & 2047; const float c = a.in[IN_C][i]; cs[k * 8 + b] = c / (1.f + expf(-c)); }
        __syncthreads();
        const int hl = lane >> 5, l32 = lane & 31;
        const float* W = a.in[IN_ADAW] + (size_t)l * DM * 6 * DM + n0 + 4 * l32;
        f32x4 acc[8];
#pragma unroll
        for (int b = 0; b < 8; ++b) acc[b] = (f32x4){0.f, 0.f, 0.f, 0.f};
        const int kbeg = wave * 256;
#pragma unroll 8
        for (int kk = 0; kk < 128; ++kk) { const int k = kbeg + 2 * kk + hl; const f32x4 w = *(const f32x4*)(W + (size_t)k * (6 * DM));
            const f32x4 c0 = *(const LAS f32x4*)(cs + k * 8), c1 = *(const LAS f32x4*)(cs + k * 8 + 4);
            acc[0] += w * c0[0]; acc[1] += w * c0[1]; acc[2] += w * c0[2]; acc[3] += w * c0[3]; acc[4] += w * c1[0]; acc[5] += w * c1[1]; acc[6] += w * c1[2]; acc[7] += w * c1[3]; }
        LAS float* part = (LAS float*)(lds + 65536);
#pragma unroll
        for (int b = 0; b < 8; ++b) { f32x4 s;
#pragma unroll
            for (int e = 0; e < 4; ++e) s[e] = swap32_add(acc[b][e], acc[b][e]);
            if (hl == 0) *(LAS f32x4*)(part + (wave * 8 + b) * 128 + 4 * l32) = s; }
        __syncthreads();
        for (int o = tid; o < 1024; o += 512) { const int b = o >> 7, col = o & 127; float s = 0.f;
#pragma unroll
            for (int w = 0; w < 8; ++w) s += part[(w * 8 + b) * 128 + col];
            MOD[(size_t)(l * 8 + b) * (6 * DM) + n0 + col] = s + a.in[IN_ADAB][l * 6 * DM + n0 + col]; }
        __syncthreads();
    }
    LAS float* scr = (LAS float*)(lds + wave * 16384);
    const int gw = vcu * 8 + wave, NGW = G * 8;
    constexpr int I_IN0 = (DM / 64) * (AB_IN / 32), I_OUT = (DM / 64) * (DM / 32), I_IN1 = (DM / 64) * (C_IN / 32), I_FFN = 48 * 2048;
    constexpr int NITEMS = I_IN0 + I_OUT + I_IN1 + I_OUT; (void)I_FFN;
    for (int it = gw; it < NITEMS; it += NGW) {
        int r = it;
        if (r < I_IN0) { const int n0 = 32 * (r % (AB_IN / 32));
            if (n0 < 3072) conv_plain_item(a.in[IN_ABWIN], DM, AB_IN, (bf16_t*)(a.ws + WS_WIN0), r, 1, scr, lane);
            else transpose_item_f8(a.in[IN_ABWIN], AB_IN, DM, 64 * (r / (AB_IN / 32)), n0, (unsigned char*)(a.ws + WS_WIN0) + (size_t)3072 * DM * 2, n0 - 3072, (n0 < 4096 ? QSCALE : 1.0f) * WIN1_SCALE, scr, lane);
            continue; } r -= I_IN0;
        if (r < I_OUT) { conv_plain_item(a.in[IN_ABWOUT], DM, DM, (bf16_t*)(a.ws + WS_WOUT0), r, 0, scr, lane); continue; } r -= I_OUT;
        if (r < I_IN1) { const int kb = r / (C_IN / 32), n0 = 32 * (r % (C_IN / 32)); transpose_item_f8(a.in[IN_CWIN], C_IN, DM, 64 * kb, n0, (unsigned char*)(a.ws + WS_WIN1), n0, (n0 < 2048 ? QSCALE : 1.0f) * WIN1_SCALE, scr, lane); continue; } r -= I_IN1;
        if (r < I_OUT) { const int kb = r / (DM / 32), nb = r % (DM / 32); transpose_item_f8(a.in[IN_CWOUT], DM, DM, 64 * kb, 32 * nb, (unsigned char*)(a.ws + WS_WOUT1), 32 * nb, WOUT_SCALE, scr, lane); continue; } r -= I_OUT;
    }
}

__device__ __forceinline__ void phase_modulate0(const Args& a, int lane, int wave, int vcu, int G) {
    const float* MOD = (const float*)(a.ws + WS_MOD); bf16_t* HB = (bf16_t*)(a.ws + WS_HB); unsigned char* H8 = (unsigned char*)(a.ws + WS_R2);
    const int gw = vcu * 8 + wave, NGW = G * 8;
#pragma unroll 1
    for (int row = gw; row < T; row += 2 * NGW) {
        f32x4 x[2][8];
#pragma unroll
        for (int p = 0; p < 2; ++p)
#pragma unroll
            for (int j = 0; j < 4; ++j)
#pragma unroll
                for (int q = 0; q < 2; ++q) x[p][2 * j + q] = *(const f32x4*)(a.in[IN_X] + (size_t)(row + p * NGW) * DM + 8 * lane + 512 * j + 4 * q);
#pragma unroll
        for (int p = 0; p < 2; ++p) { const int r = row + p * NGW; const float* mb = MOD + (size_t)(r >> 12) * (6 * DM);
#pragma unroll
            for (int j = 0; j < 4; ++j) { const int col = 8 * lane + 512 * j;
                const f32x4 s0 = *(const f32x4*)(mb + DM + col) + 1.0f, s1 = *(const f32x4*)(mb + DM + col + 4) + 1.0f, t0 = *(const f32x4*)(mb + col), t1 = *(const f32x4*)(mb + col + 4);
                const f32x4 h0 = x[p][2 * j] * s0 + t0, h1 = x[p][2 * j + 1] * s1 + t1;
                u32x4 w; w.x = cvtpk(h0[0], h0[1]); w.y = cvtpk(h0[2], h0[3]); w.z = cvtpk(h1[0], h1[1]); w.w = cvtpk(h1[2], h1[3]);
                *(u32x4*)(HB + (size_t)r * DM + col) = w;
                const f32x4 c0 = __builtin_elementwise_min(__builtin_elementwise_max(h0 * HIN1_SCALE, (f32x4){-448.f, -448.f, -448.f, -448.f}), (f32x4){448.f, 448.f, 448.f, 448.f}), c1 = __builtin_elementwise_min(__builtin_elementwise_max(h1 * HIN1_SCALE, (f32x4){-448.f, -448.f, -448.f, -448.f}), (f32x4){448.f, 448.f, 448.f, 448.f});
                unsigned w0, w1; asm volatile("v_cvt_pk_fp8_f32 %0, %1, %2" : "=v"(w0) : "v"(c0[0]), "v"(c0[1])); asm volatile("v_cvt_pk_fp8_f32 %0, %1, %2 op_sel:[0,0,1]" : "+v"(w0) : "v"(c0[2]), "v"(c0[3]));
                asm volatile("v_cvt_pk_fp8_f32 %0, %1, %2" : "=v"(w1) : "v"(c1[0]), "v"(c1[1])); asm volatile("v_cvt_pk_fp8_f32 %0, %1, %2 op_sel:[0,0,1]" : "+v"(w1) : "v"(c1[2]), "v"(c1[3]));
                *(u32x2*)(H8 + (size_t)r * DM + col) = (u32x2){w0, w1}; } }
    }
}

__device__ __forceinline__ void phase_norms(const Args& a, int tid, int lane, int G, int bx) {
    const bf16_t* P = (const bf16_t*)(a.ws + WS_R1); unsigned* NRM = (unsigned*)(a.ws + WS_CTL) + CW_NRM;
    const int wid = tid >> 6, r32 = lane & 31, hi = lane >> 5;
    for (int it = bx; it < 2048; it += G) {
        const int kind = it & 1, rest = it >> 1, combo = rest >> 4, qb = rest & 15, b = combo >> 3, h = (combo >> 1) & 3, map = combo & 1;
        const bf16_t* base = P + (size_t)(b * SEQ + qb * 256 + wid * 32 + r32) * AB_IN + (kind ? 1024 : 0) + (h * 2 + map) * 128 + hi * 8;
        float ss = 0.f, dot = 0.f;
#pragma unroll
        for (int d0 = 0; d0 < 8; ++d0) { const u32x4 v = *(const u32x4*)(base + d0 * 16);
            ss += bf_lo(v.x) * bf_lo(v.x) + bf_hi(v.x) * bf_hi(v.x) + bf_lo(v.y) * bf_lo(v.y) + bf_hi(v.y) * bf_hi(v.y) + bf_lo(v.z) * bf_lo(v.z) + bf_hi(v.z) * bf_hi(v.z) + bf_lo(v.w) * bf_lo(v.w) + bf_hi(v.w) * bf_hi(v.w);
            if (kind == 0) { const u32x4 w = *(const u32x4*)(base + 1024 + d0 * 16);
                dot += bf_lo(v.x) * bf_lo(w.x) + bf_hi(v.x) * bf_hi(w.x) + bf_lo(v.y) * bf_lo(w.y) + bf_hi(v.y) * bf_hi(w.y) + bf_lo(v.z) * bf_lo(w.z) + bf_hi(v.z) * bf_hi(w.z) + bf_lo(v.w) * bf_lo(w.w) + bf_hi(v.w) * bf_hi(w.w); } }
        ss += shx(ss, 32, lane); dot += shx(dot, 32, lane);
        float nd = fmaxf(-dot, 0.f);
#pragma unroll
        for (int o = 1; o < 32; o <<= 1) { ss = fmaxf(ss, shx(ss, o, lane)); nd = fmaxf(nd, shx(nd, o, lane)); }
        if (lane == 0) { __hip_atomic_fetch_max(NRM + (kind ? 1024 + combo : combo * 16 + qb), __float_as_uint(ss * 1.0001f), __ATOMIC_RELAXED, __HIP_MEMORY_SCOPE_AGENT);
            if (kind == 0) __hip_atomic_fetch_max(NRM + 1088 + combo * 16 + qb, __float_as_uint(nd * 1.0001f + 0.01f), __ATOMIC_RELAXED, __HIP_MEMORY_SCOPE_AGENT); }
    }
}

__device__ __forceinline__ float slope_pow2_half(int k) { return __builtin_amdgcn_exp2f(-(float)(k >> 1)) * ((k & 1) ? 0.70710678118654752f : 1.0f); }
__device__ __forceinline__ void phase_attention(const Args& a, int l, LAS unsigned char* lds, int G, int bx, const int wave0) {
    LAS char* L = (LAS char*)lds;
    const int nband = (l == 0) ? 3072 : 2048;
    int cv_n = 0;
#define CV_ITEMS(K) do { { const int cvl_ = ({ int l_; asm volatile("v_mbcnt_lo_u32_b32 %0, -1, 0\n\tv_mbcnt_hi_u32_b32 %0, -1, %0" : "=v"(l_)); l_; }); LAS float* cvs_ = (LAS float*)(lds + wave0 * 8448); \
        for (int q_ = 0; q_ < (K); ++q_) { const int it_ = (bx + cv_n * G) * 8 + wave0; if (it_ >= 48 * 2048) break; conv_ffn_item(a, l, it_, cvs_, cvl_); ++cv_n; } } } while (0)
    for (int repB_ = 0; repB_ < PH_REP(13); ++repB_)
    for (int i = 0; ; ++i) { const int u = i * G + bx; if (u >= nband) break;
        const bf16_t *Qb, *Kt, *Vt; bf16_t* Ob; float* Lb; int ldq, ldo, ldl; int q0, n, rad; float slope, sinkR;
        if (l == 0) {
            const bf16_t* P = (const bf16_t*)(a.ws + WS_R1);
            const int br = u >> 10, rem = u & 1023, b = rem >> 7, h = (rem >> 4) & 7, j = rem & 15;
            const int d = br == 0 ? 1 : (br == 1 ? 4 : 16), res = j & (d - 1), qb = br == 0 ? j : (br == 1 ? (j >> 2) : 0);
            n = SEQ / d; q0 = qb * 256; rad = 64; ldq = d * AB_IN; ldo = d * 512; ldl = d * 8;
            const size_t tok0 = (size_t)b * SEQ + res;
            Qb = P + tok0 * AB_IN + 3072 + h * 128; Kt = P + tok0 * AB_IN + 4096 + h * 128; Vt = P + tok0 * AB_IN + 5120 + h * 128;
            Ob = (bf16_t*)((unsigned char*)(a.ws + WS_R2) + (size_t)br * T * 1024 + tok0 * 1024 + h * 128);
            Lb = (float*)(a.ws + WS_LSE) + (size_t)br * T * 8 + tok0 * 8 + h;
            slope = __builtin_amdgcn_exp2f(-(float)(h + 1)) * (float)d; sinkR = -INFINITY;
        } else {
            const bf16_t* P = (const bf16_t*)(a.ws + WS_R1);
            const int combo = (u >> 9) * 8 + (u & 7), sub = (u & 511) >> 3, b = combo >> 2, kvh = combo & 3, g = sub >> 4, qb = sub & 15, hq = kvh * 4 + g;
            n = SEQ; q0 = qb * 256; rad = 128; ldq = C_IN; ldo = DM / 2; ldl = 0;
            const size_t tok0 = (size_t)b * SEQ;
            Qb = P + tok0 * C_IN + hq * 128; Kt = P + tok0 * C_IN + 2048 + kvh * 128; Vt = P + tok0 * C_IN + 2560 + kvh * 128;
            Ob = (bf16_t*)((unsigned char*)(a.ws + WS_HB) + tok0 * DM + hq * 128); Lb = nullptr;
            slope = slope_pow2_half(hq + 1); { float l2e_ = 1.4426950408889634f; asm volatile("" : "+s"(l2e_)); sinkR = a.in[IN_CSINK][hq] * l2e_; }
        }
        const int nt_tot = n / 64, nblk = rad / 64;
        int t_lo = q0 / 64 - nblk; if (t_lo < 0) t_lo = 0;
        int t_hi = q0 / 64 + 4 + nblk; if (t_hi > nt_tot) t_hi = nt_tot;
        if ((t_hi - t_lo) & 1) { if (t_hi < nt_tot) ++t_hi; else --t_lo; }
        att::attn_unit<true>(Qb + (long)(q0 * ldq), ldq, Kt + (long)(t_lo * 64 * ldq), Vt + (long)(t_lo * 64 * ldq), ldq, Ob + (long)(q0 * ldo), ldo,
                             Lb ? Lb + (long)(q0 * ldl) : nullptr, ldl, q0 - t_lo * 64, t_hi - t_lo, -slope * 1.4426950408889634f, (float)rad, sinkR, L, wave0, true);
        CV_ITEMS(((i & 3) == (bx & 3)) ? (l == 0 ? 8 : 24) : 0);
    }
    for (int repA_ = 0; repA_ < PH_REP(12); ++repA_)
    if (l == 0) {
        const bf16_t* P = (const bf16_t*)(a.ws + WS_R1); bf16_t* OA = (bf16_t*)(a.ws + WS_R3);
        const unsigned* NRM = (const unsigned*)(a.ws + WS_CTL) + CW_NRM;
        for (int i = 0; ; ++i) { const int u = i * G + bx; if (u >= 1024) break;
            const int rnd = u >> 8, x = u & 7, sub = (u & 255) >> 3, b = 2 * rnd + (sub >> 4), h = ((x >> 1) + rnd) & 3, map = x & 1, qb = (rnd & 2) ? 15 - (sub & 15) : (sub & 15), combo = (b * 4 + h) * 2 + map;
            const float slope = __builtin_amdgcn_exp2f(-2.0f * (float)(h + 1));
            const float smax2 = sqrtf(__uint_as_float(NRM[combo * 16 + qb]) * __uint_as_float(NRM[1024 + combo]));
            const float sl2 = slope * 1.4426950408889634f;
            const float mlb2 = -__uint_as_float(NRM[1088 + combo * 16 + qb]);
            const float dmf = fminf((smax2 - mlb2 + 43.3f) / sl2 + 1.0f, 65536.0f); const int dmax = (int)dmf, q0 = qb * 256;
            int lo = q0 - dmax; if (lo < 0) lo = 0; const int t_lo = lo >> 6; int t_hi = ((q0 + 255 + dmax) >> 6) + 1; if (t_hi > SEQ / 64) t_hi = SEQ / 64;
            const bf16_t* Qb = P + (size_t)(b * SEQ + q0) * AB_IN + (h * 2 + map) * 128;
            const bf16_t* Kt = P + (size_t)(b * SEQ + t_lo * 64) * AB_IN + 1024 + (h * 2 + map) * 128;
            const bf16_t* Vt = P + (size_t)(b * SEQ + t_lo * 64) * AB_IN + 2048 + h * 256;
            bf16_t* Ob = OA + (size_t)(b * SEQ + q0) * DM + (h * 2 + map) * 256;
            att::attn_unit256(Qb, AB_IN, Kt, Vt, AB_IN, Ob, DM, q0 - t_lo * 64, t_hi - t_lo, -sl2, L, wave0);
            CV_ITEMS(((i & 3) == (bx & 3)) ? 24 : 0);
        }
    }
    CV_ITEMS(48 * 2048);
}

#undef CV_ITEMS
__device__ __forceinline__ void phase_combine(const Args& a, int l, int lane, int wave, int vcu, int G) {
    bf16_t* Y = (bf16_t*)(a.ws + WS_HB);
    const int gw = vcu * 8 + wave, NGW = G * 8;
    if (l == 0) {
        const float* dl = a.in[IN_DLAM];
        const float d01 = wave_sum(dl[lane] * dl[128 + lane] + dl[64 + lane] * dl[192 + lane], lane);
        const float d23 = wave_sum(dl[256 + lane] * dl[384 + lane] + dl[320 + lane] * dl[448 + lane], lane);
        const float lam = expf(d01) - expf(d23) + LAM_INIT0;
        const f32x4 g4 = *(const f32x4*)(a.in[IN_SUBLN] + 4 * lane) * (1.0f - LAM_INIT0);
        const bf16_t* OA = (const bf16_t*)(a.ws + WS_R3); const unsigned char* OB = (const unsigned char*)(a.ws + WS_R2); const float* LSE = (const float*)(a.ws + WS_LSE);
        u32x2 an[8]; u32x4 bn[3]; float ln_[3];
#define CMB_LOAD(row_) do { const bf16_t* oa_ = OA + (size_t)(row_) * DM; const int hb_ = lane >> 3; \
            _Pragma("unroll") for (int h = 0; h < 4; ++h) { an[2 * h] = *(const u32x2*)(oa_ + h * 512 + 4 * lane); an[2 * h + 1] = *(const u32x2*)(oa_ + h * 512 + 256 + 4 * lane); } \
            { const size_t off_ = (size_t)(row_) * 1024 + 16 * lane; bn[0] = *(const u32x4*)(OB + off_); bn[1] = *(const u32x4*)(OB + (size_t)T * 1024 + off_); bn[2] = *(const u32x4*)(OB + (size_t)2 * T * 1024 + off_); } \
            ln_[0] = LSE[(size_t)(row_) * 8 + hb_]; ln_[1] = LSE[(size_t)T * 8 + (size_t)(row_) * 8 + hb_]; ln_[2] = LSE[(size_t)2 * T * 8 + (size_t)(row_) * 8 + hb_]; } while (0)
        asm volatile("" :: "v"(g4), "v"(lam));
        if (gw < T) CMB_LOAD(gw);
#pragma unroll 1
        for (int row = gw; row < T; row += NGW) {
            bf16_t* y = Y + (size_t)row * DM;
            u32x2 ac[8]; u32x4 bc[3];
#pragma unroll
            for (int k = 0; k < 8; ++k) ac[k] = an[k];
#pragma unroll
            for (int k = 0; k < 3; ++k) bc[k] = bn[k];
            const float l0 = ln_[0], l1 = ln_[1], l2 = ln_[2];
            if (row + NGW < T) CMB_LOAD(row + NGW);
#pragma unroll
            for (int h = 0; h < 4; ++h) { const u32x2 a0 = ac[2 * h], a1 = ac[2 * h + 1];
                const f32x4 o0 = {bf_lo(a0.x), bf_hi(a0.x), bf_lo(a0.y), bf_hi(a0.y)}, o1 = {bf_lo(a1.x), bf_hi(a1.x), bf_lo(a1.y), bf_hi(a1.y)};
                const f32x4 dd = o0 - o1 * lam; const float ss = wave_sum_v(dd[0] * dd[0] + dd[1] * dd[1] + dd[2] * dd[2] + dd[3] * dd[3]);
                const float rs = 1.0f / sqrtf(ss * (1.0f / 256.0f) + LN_EPS); const f32x4 r = dd * rs * g4;
                u32x2 w; w.x = cvtpk(r[0], r[1]); w.y = cvtpk(r[2], r[3]); *(u32x2*)(y + h * 256 + 4 * lane) = w; }
            const float mx = fmaxf(l0, fmaxf(l1, l2)); const float e0 = expf(l0 - mx), e1 = expf(l1 - mx), e2 = expf(l2 - mx); const float inv = 1.0f / (e0 + e1 + e2);
            const float w0 = e0 * inv * (1.0f / YATT_SCALE), w1 = e1 * inv * (1.0f / YATT_SCALE), w2 = e2 * inv * (1.0f / YATT_SCALE);
            u32x4 wv[2];
#pragma unroll
            for (int d = 0; d < 4; ++d) {
                const f32x2 x0 = __builtin_amdgcn_cvt_pk_f32_fp8((int)bc[0][d], false), x1 = __builtin_amdgcn_cvt_pk_f32_fp8((int)bc[0][d], true);
                const f32x2 y0 = __builtin_amdgcn_cvt_pk_f32_fp8((int)bc[1][d], false), y1 = __builtin_amdgcn_cvt_pk_f32_fp8((int)bc[1][d], true);
                const f32x2 z0 = __builtin_amdgcn_cvt_pk_f32_fp8((int)bc[2][d], false), z1 = __builtin_amdgcn_cvt_pk_f32_fp8((int)bc[2][d], true);
                const f32x2 s0 = x0 * w0 + y0 * w1 + z0 * w2, s1 = x1 * w0 + y1 * w1 + z1 * w2;
                wv[d >> 1][(d & 1) * 2] = cvtpk(s0.x, s0.y); wv[d >> 1][(d & 1) * 2 + 1] = cvtpk(s1.x, s1.y); }
            *(u32x4*)(y + 1024 + 16 * lane) = wv[0]; *(u32x4*)(y + 1024 + 16 * lane + 8) = wv[1];
        }
#undef CMB_LOAD
    }
}

#define LDS_BARRIER() asm volatile("s_waitcnt lgkmcnt(0)\n\ts_barrier" ::: "memory")
constexpr int RP = 1;
__device__ __forceinline__ void phase_ln1_router(const Args& a, int l, const float* __restrict__ X, LAS unsigned char* lds, int tid, int lane, int wave, int vcu, int G) {
    const bool xh = l != 0; const unsigned short* Xh = (const unsigned short*)(a.ws + WS_X1) + (size_t)T * DM;
    const float* MOD = (const float*)(a.ws + WS_MOD); const bf16_t* YO = (const bf16_t*)(a.ws + WS_R3);
    unsigned short* X1 = (unsigned short*)(a.ws + WS_X1); unsigned char* HB = (unsigned char*)(a.ws + WS_HB); float* AFF = (float*)(a.ws + WS_AFF);
    LAS f32x4* WL = (LAS f32x4*)lds;
    LAS f32x2* stat = (LAS f32x2*)(lds + 132096);
    LAS float* plog = (LAS float*)(lds + 132096 + 256);
    const int pr = wave >> 1, hf = wave & 1;
    { const float* Wr = a.in[IN_ROUTER] + (size_t)l * DM * NE;
      for (int i = tid; i < DM * 4; i += 512) { const int col = i >> 2, q = i & 3; const f32x4 w = *(const f32x4*)(Wr + (size_t)col * NE + 4 * q);
          WL[((((col >> 10) * 4 + ((col >> 8) & 3)) * 4 + (col & 3)) * 4 + q) * 64 + ((col & 255) >> 2)] = w; } }
    f32x4 lng[4], lnb[4];
#pragma unroll
    for (int j = 0; j < 4; ++j) { const int c = 1024 * hf + 256 * j + 4 * lane; lng[j] = *(const f32x4*)(a.in[IN_LNG] + (size_t)(l * 2 + 0) * DM + c); lnb[j] = *(const f32x4*)(a.in[IN_LNB] + (size_t)(l * 2 + 0) * DM + c); }
    asm volatile("" :: "v"(lng[0]), "v"(lng[1]), "v"(lng[2]), "v"(lng[3]), "v"(lnb[0]), "v"(lnb[1]), "v"(lnb[2]), "v"(lnb[3]));
    __syncthreads();
    const LAS f32x4* wl = WL + hf * (16 * 4 * 64) + lane;
    for (int blk = vcu; blk < T / 128; blk += G) {
        const int b = blk >> 5; const float* mb = MOD + (size_t)(l * 8 + b) * (6 * DM);
        f32x4 g1[4], sh2[4], sc2[4];
#pragma unroll
        for (int j = 0; j < 4; ++j) { const int c = 1024 * hf + 256 * j + 4 * lane; g1[j] = *(const f32x4*)(mb + 2 * DM + c); sh2[j] = *(const f32x4*)(mb + 3 * DM + c); sc2[j] = *(const f32x4*)(mb + 4 * DM + c) + 1.0f; }
        asm volatile("" :: "v"(g1[0]), "v"(g1[1]), "v"(g1[2]), "v"(g1[3]), "v"(sh2[0]), "v"(sh2[1]), "v"(sh2[2]), "v"(sh2[3]), "v"(sc2[0]), "v"(sc2[1]), "v"(sc2[2]), "v"(sc2[3]));
        f32x4 xr[RP][4]; u32x2 yr[RP][4];
#pragma unroll
        for (int i = 0; i < RP; ++i)
#pragma unroll
            for (int j = 0; j < 4; ++j) { const size_t off = (size_t)(blk * 128 + pr * RP + i) * DM + 1024 * hf + 256 * j + 4 * lane; if (xh) { const u32x2 t_ = *(const u32x2*)(Xh + off); xr[i][j] = (f32x4){__uint_as_float(t_.x), __uint_as_float(t_.y), 0.f, 0.f}; } else xr[i][j] = *(const f32x4*)(X + off); if (xh) yr[i][j] = (u32x2){*(const unsigned*)((const unsigned char*)YO + off), 0u}; else yr[i][j] = *(const u32x2*)(YO + off); }
#pragma unroll 1
        for (int bt = 0; bt < 32 / RP; ++bt) {
            const int row0 = blk * 128 + bt * (4 * RP) + pr * RP;
            f32x4 v[RP][4];
#pragma unroll
            for (int i = 0; i < RP; ++i)
#pragma unroll
                for (int j = 0; j < 4; ++j) { f32x4 y = {bf_lo(yr[i][j].x), bf_hi(yr[i][j].x), bf_lo(yr[i][j].y), bf_hi(yr[i][j].y)};
                    if (xh) { const f32x2 ya_ = __builtin_amdgcn_cvt_pk_f32_fp8((int)yr[i][j].x, false), yb_ = __builtin_amdgcn_cvt_pk_f32_fp8((int)yr[i][j].x, true); y = (f32x4){ya_.x, ya_.y, yb_.x, yb_.y} * (1.0f / YO1_SCALE); }
                    f32x4 xv = xr[i][j]; if (xh) { const unsigned a_ = __float_as_uint(xv[0]), b_ = __float_as_uint(xv[1]); xv = (f32x4){h_lo(a_), h_hi(a_), h_lo(b_), h_hi(b_)}; }
                    v[i][j] = xv * ALPHA + g1[j] * y; }
            if (bt + 1 < 32 / RP) {
#pragma unroll
                for (int i = 0; i < RP; ++i)
#pragma unroll
                    for (int j = 0; j < 4; ++j) { const size_t off = (size_t)(row0 + 4 * RP + i) * DM + 1024 * hf + 256 * j + 4 * lane; if (xh) { const u32x2 t_ = *(const u32x2*)(Xh + off); xr[i][j] = (f32x4){__uint_as_float(t_.x), __uint_as_float(t_.y), 0.f, 0.f}; } else xr[i][j] = *(const f32x4*)(X + off); if (xh) yr[i][j] = (u32x2){*(const unsigned*)((const unsigned char*)YO + off), 0u}; else yr[i][j] = *(const u32x2*)(YO + off); } }
#pragma unroll
            for (int i = 0; i < RP; ++i) { const f32x4 s4 = (v[i][0] + v[i][1]) + (v[i][2] + v[i][3]); const float mw = wave_sum_v((s4[0] + s4[1]) + (s4[2] + s4[3])) * (1.0f / 1024.0f);
                f32x4 q4 = {0.f, 0.f, 0.f, 0.f};
#pragma unroll
                for (int j = 0; j < 4; ++j) { const f32x4 d = v[i][j] - mw; q4 += d * d; }
                const float q = wave_sum_v((q4[0] + q4[1]) + (q4[2] + q4[3]));
                if (lane == 0) stat[(pr * RP + i) * 2 + hf] = (f32x2){mw, q}; }
            LDS_BARRIER();
            f32x4 p[RP][4];
#pragma unroll
            for (int i = 0; i < RP; ++i) {
                const f32x2 s0 = stat[(pr * RP + i) * 2], s1 = stat[(pr * RP + i) * 2 + 1];
                const float mean = (s0[0] + s1[0]) * 0.5f, d0 = s0[0] - mean, d1 = s1[0] - mean, m2 = (s0[1] + s1[1]) + 1024.0f * (d0 * d0 + d1 * d1);
                const float rstd = 1.0f / sqrtf(m2 * (1.0f / 2048.0f) + LN_EPS);
#pragma unroll
                for (int j = 0; j < 4; ++j) { const f32x4 x1 = (v[i][j] - mean) * rstd * lng[j] + lnb[j]; const f32x4 h2 = x1 * sc2[j] + sh2[j];
                    const size_t off = (size_t)(row0 + i) * DM + 1024 * hf + 256 * j + 4 * lane;
                    *(u32x2*)(X1 + off) = (u32x2){pkh(x1[0], x1[1]), pkh(x1[2], x1[3])};
                    const f32x4 hs = __builtin_elementwise_min(__builtin_elementwise_max(h2 * H2_SCALE, (f32x4){-448.f, -448.f, -448.f, -448.f}), (f32x4){448.f, 448.f, 448.f, 448.f});
                    int hw = __builtin_amdgcn_cvt_pk_fp8_f32(hs[0], hs[1], 0, false); hw = __builtin_amdgcn_cvt_pk_fp8_f32(hs[2], hs[3], hw, true);
                    *(int*)(HB + off) = hw;
                    v[i][j] = h2; }
#pragma unroll
                for (int q = 0; q < 4; ++q) p[i][q] = (f32x4){0.f, 0.f, 0.f, 0.f};
            }
#pragma unroll
            for (int j = 0; j < 4; ++j)
#pragma unroll
                for (int t = 0; t < 4; ++t) {
                    f32x4 w[4];
#pragma unroll
                    for (int q = 0; q < 4; ++q) w[q] = wl[((j * 4 + t) * 4 + q) * 64];
#pragma unroll
                    for (int i = 0; i < RP; ++i)
#pragma unroll
                        for (int q = 0; q < 4; ++q) p[i][q] += w[q] * v[i][j][t];
                    if (t & 1) asm volatile("" ::: "memory"); }
#pragma unroll
            for (int i = 0; i < RP; ++i) { float t8[8], t4[4], t2[2];
#pragma unroll
                for (int k = 0; k < 8; ++k) t8[k] = swap32_add(p[i][k >> 2][k & 3], p[i][2 + (k >> 2)][k & 3]);
#pragma unroll
                for (int k = 0; k < 4; ++k) t4[k] = swap16_add(t8[k], t8[4 + k]);
                const bool up3 = (lane & 8) != 0;
#pragma unroll
                for (int k = 0; k < 2; ++k) { const float mine = up3 ? t4[2 + k] : t4[k], theirs = up3 ? t4[k] : t4[2 + k]; t2[k] = sum8_dpp(mine + dpp_mov<0x128>(theirs)); }
                if ((lane & 7) == 0) *(LAS f32x2*)(plog + ((pr * RP + i) * 2 + hf) * 16 + (lane >> 3) * 2) = (f32x2){t2[0], t2[1]}; }
            LDS_BARRIER();
            if (lane < 16 && wave < 4 * RP) { const int r8 = wave; const float lg = plog[(r8 * 2) * 16 + lane] + plog[(r8 * 2 + 1) * 16 + lane];
                float mx = lg;
#pragma unroll
                for (int o = 1; o < 16; o <<= 1) mx = fmaxf(mx, shx(mx, o, lane));
                const float ex = expf(lg - mx); float sm = ex;
#pragma unroll
                for (int o = 1; o < 16; o <<= 1) sm += shx(sm, o, lane);
                const int row = blk * 128 + bt * (4 * RP) + r8; AFF[((size_t)(b * NE + lane)) * SEQ + (row & (SEQ - 1))] = ex / sm; }
        }
        LDS_BARRIER();
    }
    __syncthreads();
}

__device__ __forceinline__ int block_excl_scan(int v, LAS int* wsum, int lane, int wave, int& total) {
    int x = v;
#pragma unroll
    for (int o = 1; o < 64; o <<= 1) { const int y = shup_i(x, o, lane); if (lane >= o) x += y; }
    if (lane == 63) wsum[wave] = x;
    __syncthreads();
    int off = 0, tot = 0;
#pragma unroll
    for (int w = 0; w < 8; ++w) { const int s = wsum[w]; off += (w < wave) ? s : 0; tot += s; }
    __syncthreads();
    total = tot; return off + x - v;
}
__device__ __forceinline__ void phase_topk(const Args& a, LAS unsigned char* lds, int tid, int lane, int wave, int G, int bx) {
    const float* AFF = (const float*)(a.ws + WS_AFF); int* IDX = (int*)(a.ws + WS_IDX); int* INVC = (int*)(a.ws + WS_INVC); float* INVG = (float*)(a.ws + WS_INVG);
    LAS unsigned* hist = (LAS unsigned*)lds;
    LAS int* wsum = (LAS int*)(lds + 1024);
    LAS int* selw = (LAS int*)(lds + 1024 + 64);
    for (int it = bx; it < NB * NE; it += G) {
        const int b = it >> 4, e = it & 15;
        const float* av = AFF + (size_t)it * SEQ + 8 * tid;
        const f32x4 v0 = *(const f32x4*)av, v1 = *(const f32x4*)(av + 4);
        unsigned u[8] = {__float_as_uint(v0[0]), __float_as_uint(v0[1]), __float_as_uint(v0[2]), __float_as_uint(v0[3]), __float_as_uint(v1[0]), __float_as_uint(v1[1]), __float_as_uint(v1[2]), __float_as_uint(v1[3])};
        unsigned prefix = 0u; int kk = CAP;
#pragma unroll
        for (int pass = 0; pass < 4; ++pass) {
            const int shift = 24 - 8 * pass; const unsigned mhi = pass == 0 ? 0u : (0xFFFFFFFFu << (shift + 8));
            if (tid < 256) hist[tid] = 0u;
            __syncthreads();
#pragma unroll
            for (int i = 0; i < 8; ++i) if ((u[i] & mhi) == prefix) __hip_atomic_fetch_add(&hist[(u[i] >> shift) & 255u], 1u, __ATOMIC_RELAXED, __HIP_MEMORY_SCOPE_WORKGROUP);
            __syncthreads();
            const int bin = 255 - tid; const int h = tid < 256 ? (int)hist[bin] : 0; int tot;
            const int excl = block_excl_scan(h, wsum, lane, wave, tot);
            if (tid < 256 && excl < kk && kk <= excl + h) { selw[0] = bin; selw[1] = excl; }
            __syncthreads();
            prefix |= (unsigned)selw[0] << shift; kk -= selw[1];
            __syncthreads();
        }
        int ngt = 0, neq = 0;
#pragma unroll
        for (int i = 0; i < 8; ++i) { ngt += u[i] > prefix ? 1 : 0; neq += u[i] == prefix ? 1 : 0; }
        int tgt, teq;
        int pg = block_excl_scan(ngt, wsum, lane, wave, tgt);
        int pe = block_excl_scan(neq, wsum, lane, wave, teq);
#pragma unroll
        for (int i = 0; i < 8; ++i) { const int s = 8 * tid + i; int c = -1;
            if (u[i] > prefix) c = pg++;
            else if (u[i] == prefix) { if (pe < kk) c = tgt + pe; ++pe; }
            const size_t tok = (size_t)b * SEQ + s;
            INVC[tok * NE + e] = c; INVG[tok * NE + e] = __uint_as_float(u[i]);
            if (c >= 0) IDX[(size_t)it * CAP + c] = (int)(((unsigned)b * SEQ + (unsigned)s) * (unsigned)DM); }
        __syncthreads();
    }
}

__device__ __forceinline__ void phase_gather(const Args& a, int lane, int wave, int vcu, int G) {
    const int* IDX = (const int*)(a.ws + WS_IDX); const bf16_t* HB = (const bf16_t*)(a.ws + WS_HB); bf16_t* XG = (bf16_t*)(a.ws + WS_R1);
    for (int slot = vcu * 8 + wave; slot < NSLOT; slot += G * 8) {
        const int b = slot >> 13, tok = IDX[slot]; const unsigned char* src = (const unsigned char*)HB + ((size_t)b * SEQ + tok) * DM; unsigned char* dst = (unsigned char*)XG + (size_t)slot * DM;
        u32x4 t[2];
#pragma unroll
        for (int j = 0; j < 2; ++j) t[j] = *(const u32x4*)(src + 16 * lane + 1024 * j);
#pragma unroll
        for (int j = 0; j < 2; ++j) *(u32x4*)(dst + 16 * lane + 1024 * j) = t[j];
    }
}

__device__ __forceinline__ void phase_ffn_combine(const Args& a, int l, float* __restrict__ OUT, LAS unsigned char* lds, int tid, int lane, int wave, int vcu, int G) {
    const float* MOD = (const float*)(a.ws + WS_MOD); const unsigned short* X1 = (const unsigned short*)(a.ws + WS_X1); const unsigned char* YD8 = (const unsigned char*)(a.ws + WS_R3);
    const int* INVC = (const int*)(a.ws + WS_INVC); const float* INVG = (const float*)(a.ws + WS_INVG); bf16_t* HB = (bf16_t*)(a.ws + WS_HB);
    LAS float* vg2 = (LAS float*)lds; LAS float* vlg = vg2 + DM; LAS float* vlb = vlg + DM; LAS float* vsc = vlb + DM; LAS float* vsh = vsc + DM;
    for (int blk = vcu; blk < T / 128; blk += G) {
        const int b = blk >> 5; const float* mb = MOD + (size_t)(l * 8 + b) * (6 * DM); const float* mbn = MOD + (size_t)(8 + b) * (6 * DM);
        __syncthreads();
        for (int i = tid; i < DM; i += 512) { vg2[i] = mb[5 * DM + i]; vlg[i] = a.in[IN_LNG][(size_t)(l * 2 + 1) * DM + i]; vlb[i] = a.in[IN_LNB][(size_t)(l * 2 + 1) * DM + i];
            vsc[i] = mbn[DM + i] + 1.0f; vsh[i] = mbn[i]; }
        __syncthreads();
        int ic_n = lane < 16 ? INVC[(size_t)(blk * 128 + wave * 16) * NE + lane] : -1; float ig_n = lane < 16 ? INVG[(size_t)(blk * 128 + wave * 16) * NE + lane] : 0.f;
        u32x4 xn_[4];
#pragma unroll
        for (int j = 0; j < 2; ++j)
#pragma unroll
            for (int q = 0; q < 2; ++q) xn_[2 * j + q] = *(const u32x4*)(X1 + (size_t)(blk * 128 + wave * 16) * DM + 16 * lane + 1024 * j + 8 * q);
#pragma unroll 1
        for (int r = 0; r < 16; ++r) {
            const int row = blk * 128 + wave * 16 + r;
            const int ic = ic_n; const float ig = ig_n; u32x4 xc[4];
#pragma unroll
            for (int j = 0; j < 4; ++j) xc[j] = xn_[j];
            if (r + 1 < 16) { ic_n = lane < 16 ? INVC[(size_t)(row + 1) * NE + lane] : -1; ig_n = lane < 16 ? INVG[(size_t)(row + 1) * NE + lane] : 0.f;
#pragma unroll
                for (int j = 0; j < 2; ++j)
#pragma unroll
                    for (int q = 0; q < 2; ++q) xn_[2 * j + q] = *(const u32x4*)(X1 + (size_t)(row + 1) * DM + 16 * lane + 1024 * j + 8 * q); }
            float y[32];
#pragma unroll
            for (int k = 0; k < 32; ++k) y[k] = 0.f;
            unsigned mask = (unsigned)__builtin_amdgcn_ballot_w64(ic >= 0) & 0xFFFFu;
            while (mask) {
                int ek[3]; float gk[3]; const unsigned char* yr[3];
#pragma unroll
                for (int k = 0; k < 3; ++k) { const bool ok = mask != 0u; const int e = ok ? __builtin_ctz(mask) : 0; if (ok) mask &= mask - 1u; ek[k] = e;
                    const int c = __builtin_amdgcn_readlane(ic, e); gk[k] = ok ? __uint_as_float((unsigned)__builtin_amdgcn_readlane((int)__float_as_uint(ig), e)) * (1.0f / YD_SCALE) : 0.f;
                    yr[k] = YD8 + ((size_t)(b * NE + e) * CAP + (ok ? c : 0)) * DM + 16 * lane; }
                u32x4 w[3][2];
#pragma unroll
                for (int k = 0; k < 3; ++k)
#pragma unroll
                    for (int j = 0; j < 2; ++j) w[k][j] = *(const u32x4*)(yr[k] + 1024 * j);
#pragma unroll
                for (int k = 0; k < 3; ++k)
#pragma unroll
                    for (int j = 0; j < 2; ++j) { const float gs = gk[k];
#pragma unroll
                        for (int d = 0; d < 4; ++d) { const f32x2 lo = __builtin_amdgcn_cvt_pk_f32_fp8((int)w[k][j][d], false), hi = __builtin_amdgcn_cvt_pk_f32_fp8((int)w[k][j][d], true);
                            y[16 * j + 4 * d + 0] += gs * lo[0]; y[16 * j + 4 * d + 1] += gs * lo[1]; y[16 * j + 4 * d + 2] += gs * hi[0]; y[16 * j + 4 * d + 3] += gs * hi[1]; } }
            }
            float v[32]; float s = 0.f;
#pragma unroll
            for (int j = 0; j < 2; ++j)
#pragma unroll
                for (int q = 0; q < 4; ++q) { const int col = 16 * lane + 1024 * j + 4 * q; const unsigned xw0 = xc[2 * j + (q >> 1)][(q & 1) * 2], xw1 = xc[2 * j + (q >> 1)][(q & 1) * 2 + 1]; const f32x4 xa = {h_lo(xw0), h_hi(xw0), h_lo(xw1), h_hi(xw1)}; const f32x4 ga = *(const LAS f32x4*)(vg2 + col);
#pragma unroll
                    for (int t = 0; t < 4; ++t) v[16 * j + 4 * q + t] = xa[t] * ALPHA + ga[t] * y[16 * j + 4 * q + t]; }
#pragma unroll
            for (int k = 0; k < 32; ++k) s += v[k];
            const float mean = wave_sum(s, lane) * (1.0f / DM); float q2 = 0.f;
#pragma unroll
            for (int k = 0; k < 32; ++k) { v[k] -= mean; q2 += v[k] * v[k]; }
            const float rstd = 1.0f / sqrtf(wave_sum(q2, lane) * (1.0f / DM) + LN_EPS);
#pragma unroll
            for (int j = 0; j < 2; ++j) { u32x4 hw;
#pragma unroll
                for (int q = 0; q < 4; ++q) { const int col = 16 * lane + 1024 * j + 4 * q;
                    const f32x4 la = *(const LAS f32x4*)(vlg + col), ba = *(const LAS f32x4*)(vlb + col);
                    f32x4 oa;
#pragma unroll
                    for (int t = 0; t < 4; ++t) oa[t] = v[16 * j + 4 * q + t] * rstd * la[t] + ba[t];
                    if (l == 0) *(u32x2*)((unsigned short*)(a.ws + WS_X1) + (size_t)T * DM + (size_t)row * DM + col) = (u32x2){pkh(oa[0], oa[1]), pkh(oa[2], oa[3])};
                    else *(f32x4*)(OUT + (size_t)row * DM + col) = oa;
                    if (l == 0) { const f32x4 sa = *(const LAS f32x4*)(vsc + col), ha = *(const LAS f32x4*)(vsh + col); const f32x4 h0 = oa * sa + ha;
                        const f32x4 hs = __builtin_elementwise_min(__builtin_elementwise_max(h0 * HIN1_SCALE, (f32x4){-448.f, -448.f, -448.f, -448.f}), (f32x4){448.f, 448.f, 448.f, 448.f});
                        unsigned w8; asm volatile("v_cvt_pk_fp8_f32 %0, %1, %2" : "=v"(w8) : "v"(hs[0]), "v"(hs[1])); asm volatile("v_cvt_pk_fp8_f32 %0, %1, %2 op_sel:[0,0,1]" : "+v"(w8) : "v"(hs[2]), "v"(hs[3])); hw[q] = w8; } }
                if (l == 0) *(u32x4*)((unsigned char*)HB + (size_t)row * DM + 16 * lane + 1024 * j) = hw; }
        }
    }
    if (l == 0) {
        __syncthreads();
        LAS float* scr = (LAS float*)(lds + wave * 16384);
        (void)scr;
    }
}

__device__ __forceinline__ Args load_args(unsigned long long kp) {
    const __attribute__((address_space(4))) Args* p = (const __attribute__((address_space(4))) Args*)kp;
    Args A;
#pragma unroll
    for (int i = 0; i < 17; ++i) A.in[i] = (const float*)(GAS const float*)(uintptr_t)p->in[i];
    A.out = (float*)(GAS float*)(uintptr_t)p->out; A.ws = (unsigned char*)(GAS unsigned char*)(uintptr_t)p->ws; A.ph_lo = p->ph_lo; A.ph_hi = p->ph_hi;
    return A;
}
constexpr int NPHASE = 22;
#ifndef PH_MASK
#define PH_MASK 0xFFF
#endif
#define PH_EN(k) ((((PH_MASK) >> (k)) & 1) != 0)

__global__ void __launch_bounds__(512, 2) fwd(Args args) {
    extern __shared__ __attribute__((aligned(16))) unsigned char lds_raw[];
    LAS unsigned char* lds = (LAS unsigned char*)lds_raw;
    const int tid0 = threadIdx.x; const int wave0 = __builtin_amdgcn_readfirstlane(tid0 >> 6);
#define LAUNDER() int tid = wave0 * 64 + ({ int l_; asm volatile("v_mbcnt_lo_u32_b32 %0, -1, 0\n\tv_mbcnt_hi_u32_b32 %0, -1, %0" : "=v"(l_)); l_; }); const int lane = tid & 63, wave = __builtin_amdgcn_readfirstlane(tid >> 6); (void)lane; (void)wave; LAUNDER_WS()
#define LAUNDER_WS() int bxl = bx, Gl = G; asm volatile("" : "+s"(bxl), "+s"(Gl)); const int vcul = (Gl % 8 == 0) ? (bxl % 8) * (Gl / 8) + bxl / 8 : bxl; (void)vcul; \
    unsigned long long kp_ = (unsigned long long)(uintptr_t)__builtin_amdgcn_kernarg_segment_ptr(); asm volatile("" : "+s"(kp_)); const Args A = load_args(kp_)
    const int G = gridDim.x; const int bx = blockIdx.x; const int vcu = (G % 8 == 0) ? (bx % 8) * (G / 8) + bx / 8 : bx;
    volatile LAS unsigned* MISC = (volatile LAS unsigned*)(lds + MISC_OFF);
    for (int u = tid0; u < (LDS_BYTES - RING_BYTES) / 4; u += 512) ((LAS unsigned*)(lds + RING_BYTES))[u] = 0u;
    __syncthreads();
    const int lo = args.ph_lo, hi = args.ph_hi;
    XcdBarrier bar; bar.bar = (unsigned*)(args.ws + WS_CTL) + CW_BAR; bar.x = 0; bar.st = nullptr;
    if (hi - lo > 1) bar = xcd_barrier_post((unsigned*)(args.ws + WS_CTL) + CW_BAR, MISC + 8);
#define IN(k) (lo <= (k) && (k) < hi)
#define BAR_SYNC() do { XcdBarrier b2_ = bar; { unsigned long long w_ = (unsigned long long)(uintptr_t)b2_.bar; asm volatile("" : "+s"(w_)); b2_.bar = (unsigned*)(GAS unsigned*)(uintptr_t)w_; } const int ln_ = ({ int l_; asm volatile("v_mbcnt_lo_u32_b32 %0, -1, 0\n\tv_mbcnt_hi_u32_b32 %0, -1, %0" : "=v"(l_)); l_; }); xcd_barrier(b2_, wave0 == 0 && ln_ == 0); } while (0)
#define SEAM(k) do { if (IN(k) && IN((k) + 1)) BAR_SYNC(); } while (0)

    for (int rep_ = 0; rep_ < PH_REP(0); ++rep_) if (PH_EN(0) && IN(0)) { if (rep_ > 0 && hi - lo > 1) BAR_SYNC(); LAUNDER(); phase_prologue(A, lds, tid, lane, wave, vcul, Gl, bxl); } SEAM(0);
    for (int rep_ = 0; rep_ < PH_REP(1); ++rep_) if (PH_EN(1) && IN(1)) { if (rep_ > 0 && hi - lo > 1) BAR_SYNC(); LAUNDER(); phase_modulate0(A, lane, wave, vcul, Gl); } SEAM(1);
    for (int l = 0; l < 2; ++l) {
        const int pb = 2 + 10 * l;
        for (int rep_ = 0; rep_ < PH_REP(2); ++rep_) if (PH_EN(2) && IN(pb + 0)) { if (rep_ > 0 && hi - lo > 1) BAR_SYNC();
            LAUNDER_WS(); const int N = l == 0 ? AB_IN : C_IN;
            pg8::StaticOrder S; S.init(T, C_IN, Gl, bxl);
            if (l == 0) { pg8::Gemm g{(const bf16_t*)(A.ws + WS_HB), (const bf16_t*)(A.ws + WS_WIN0), T, C_IN, DM, nullptr};
                pg8::EpiBf16 E{(bf16_t*)(A.ws + WS_R1), N, 0xFFFF, 1.0f};
                pg8::gemm_phase<pg8::EpiBf16, pg8::StaticOrder, true, true>(lds, g, S, E, wave0); }
            { pg8::Gemm g{(const bf16_t*)(A.ws + (l == 0 ? WS_R2 : WS_HB)), (const bf16_t*)(A.ws + (l == 0 ? WS_WIN0 + (size_t)3072 * DM * 2 : WS_WIN1)), T, C_IN, DM / 2, nullptr};
                pg8::EpiBf16 E{(bf16_t*)(A.ws + WS_R1) + (l == 0 ? 3072 : 0), N, 0xFFFF, 1.0f / (HIN1_SCALE * WIN1_SCALE)};
                pg8::gemm_phase<pg8::EpiBf16, pg8::StaticOrder, true, true, true>(lds, g, S, E, wave0); }
        } SEAM(pb + 0);
        for (int rep_ = 0; rep_ < PH_REP(3); ++rep_) if (PH_EN(3) && IN(pb + 1)) { if (rep_ > 0 && hi - lo > 1) BAR_SYNC(); if (l == 0) { LAUNDER(); phase_norms(A, tid, lane, Gl, bxl); BAR_SYNC(); } { LAUNDER_WS(); phase_attention(A, l, lds, Gl, bxl, wave0); } } SEAM(pb + 1);
        for (int rep_ = 0; rep_ < PH_REP(4); ++rep_) if (PH_EN(4) && IN(pb + 2) && l == 0) { if (rep_ > 0 && hi - lo > 1) BAR_SYNC(); LAUNDER(); phase_combine(A, l, lane, wave, vcul, Gl); } if (l == 0) SEAM(pb + 2);
        for (int rep_ = 0; rep_ < PH_REP(5); ++rep_) if (PH_EN(5) && IN(pb + 3)) { if (rep_ > 0 && hi - lo > 1) BAR_SYNC();
            LAUNDER_WS();
            pg8::StaticOrder S; S.init(T, DM, Gl, bxl);
            if (l == 0) { pg8::Gemm g{(const bf16_t*)(A.ws + WS_HB), (const bf16_t*)(A.ws + WS_WOUT0), T, DM, DM, nullptr};
                pg8::EpiBf16 E{(bf16_t*)(A.ws + WS_R3), DM, 0xFFFF, 1.0f};
                pg8::gemm_phase<pg8::EpiBf16, pg8::StaticOrder, true, true>(lds, g, S, E, wave0); }
            else { pg8::Gemm g{(const bf16_t*)(A.ws + WS_HB), (const bf16_t*)(A.ws + WS_WOUT1), T, DM, DM / 2, nullptr};
                pg8::EpiF8 E{(unsigned char*)(A.ws + WS_R3), DM, 0xFFFF, YO1_SCALE / (YATT_SCALE * WOUT_SCALE)};
                pg8::gemm_phase<pg8::EpiF8, pg8::StaticOrder, true, true, true>(lds, g, S, E, wave0); }
        } SEAM(pb + 3);
        for (int rep_ = 0; rep_ < PH_REP(6); ++rep_) if (PH_EN(6) && IN(pb + 4)) { if (rep_ > 0 && hi - lo > 1) BAR_SYNC(); LAUNDER(); phase_ln1_router(A, l, l == 0 ? A.in[IN_X] : (const float*)A.out, lds, tid, lane, wave, vcul, Gl); } SEAM(pb + 4);
        for (int rep_ = 0; rep_ < PH_REP(7); ++rep_) if (PH_EN(7) && IN(pb + 5)) { if (rep_ > 0 && hi - lo > 1) BAR_SYNC(); LAUNDER(); phase_topk(A, lds, tid, lane, wave, Gl, bxl); } SEAM(pb + 5);
        for (int rep_ = 0; rep_ < PH_REP(9); ++rep_) if (PH_EN(9) && IN(pb + 7)) { if (rep_ > 0 && hi - lo > 1) BAR_SYNC();
            LAUNDER_WS();
            pg8::Gemm g{(const bf16_t*)(A.ws + WS_HB), (const bf16_t*)(A.ws + WS_WGU), NSLOT, NE * 4096, DM / 2, (const unsigned*)(A.ws + WS_IDX)};
            pg8::GroupedOrder<16> S; S.init(Gl, bxl);
            pg8::EpiSwiGLU<true> E{(bf16_t*)(A.ws + WS_R2), EH, 15, HID_SCALE, 1.0f / (WGU_SCALE * H2_SCALE)};
            pg8::gemm_phase<pg8::EpiSwiGLU<true>, pg8::GroupedOrder<16>, true, true, true, true>(lds, g, S, E, wave0);
        } SEAM(pb + 7);
        for (int rep_ = 0; rep_ < PH_REP(10); ++rep_) if (PH_EN(10) && IN(pb + 8)) { if (rep_ > 0 && hi - lo > 1) BAR_SYNC();
            LAUNDER_WS();
            pg8::Gemm g{(const bf16_t*)(A.ws + WS_R2), (const bf16_t*)(A.ws + WS_WDN), NSLOT, NE * DM, EH / 2, nullptr};
            pg8::GroupedOrder<8> S; S.init(Gl, bxl);
            pg8::EpiF8 E{(unsigned char*)(A.ws + WS_R3), DM, 7, YD_SCALE / (WDN_SCALE * HID_SCALE)};
            pg8::gemm_phase<pg8::EpiF8, pg8::GroupedOrder<8>, true, true, true>(lds, g, S, E, wave0);
        } SEAM(pb + 8);
        for (int rep_ = 0; rep_ < PH_REP(11); ++rep_) if (PH_EN(11) && IN(pb + 9)) { if (rep_ > 0 && hi - lo > 1) BAR_SYNC(); LAUNDER(); phase_ffn_combine(A, l, A.out, lds, tid, lane, wave, vcul, Gl); } SEAM(pb + 9);
    }
#undef IN
#undef SEAM
#undef BAR_SYNC
}

extern "C" void kernel_launch(void* const* d_in, const int* in_sizes, int n_in, void* d_out, int out_size, void* d_ws, size_t ws_size, hipStream_t stream) {
    static int grid = 0;
    if (grid == 0) {
        if (n_in != 17 || out_size != T * DM || ws_size < WS_END) { fprintf(stderr, "kernel_launch: unexpected shapes (n_in %d out %d ws %zu, need ws >= %zu)\n", n_in, out_size, ws_size, (size_t)WS_END); grid = -1; return; }
        int dev = 0, cus = 0, per_cu = 0;
        if (hipGetDevice(&dev) != hipSuccess || hipDeviceGetAttribute(&cus, hipDeviceAttributeMultiprocessorCount, dev) != hipSuccess) { grid = -1; return; }
        if (hipFuncSetAttribute((const void*)fwd, hipFuncAttributeMaxDynamicSharedMemorySize, LDS_BYTES) != hipSuccess) { fprintf(stderr, "kernel_launch: hipFuncSetAttribute failed\n"); grid = -1; return; }
        if (hipOccupancyMaxActiveBlocksPerMultiprocessor(&per_cu, (const void*)fwd, 512, LDS_BYTES) != hipSuccess || per_cu < 1) fprintf(stderr, "kernel_launch: occupancy query says %d\n", per_cu);
        (void)hipGetLastError();
        grid = cus;
    }
    if (grid < 0) return;
    (void)hipMemsetAsync((char*)d_ws + WS_CTL, 0, CTL_ZERO_BYTES, stream);
    Args a{};
    for (int i = 0; i < 17; ++i) a.in[i] = (const float*)d_in[i];
    a.out = (float*)d_out; a.ws = (unsigned char*)d_ws;
#if MK_SINGLE
    a.ph_lo = 0; a.ph_hi = NPHASE;
    hipLaunchKernelGGL(fwd, dim3(grid), dim3(512), LDS_BYTES, stream, a);
#else
    for (int p = 0; p < NPHASE; ++p) { a.ph_lo = p; a.ph_hi = p + 1; hipLaunchKernelGGL(fwd, dim3(grid), dim3(512), LDS_BYTES, stream, a); }
#endif
}
```

```cpp
#include <hip/hip_runtime.h>
#include <cstdio>
#include <cstdint>
#ifndef MK_SINGLE
#define MK_SINGLE 1
#endif
namespace pg8 {
#define PG8_LAS __attribute__((address_space(3)))
typedef unsigned short bf16_t;
typedef short bf16x8 __attribute__((ext_vector_type(8)));
typedef float f32x4 __attribute__((ext_vector_type(4)));
typedef unsigned u32x4 __attribute__((ext_vector_type(4)));
typedef int i32x4 __attribute__((ext_vector_type(4)));
typedef int i32x8 __attribute__((ext_vector_type(8)));
constexpr int BM = 256, BK = 64, HALF = 128, HTB = HALF * BK * 2  , STAGE_BYTES = 8 * HTB, NXCD = 8, WGM = 8;

__host__ __device__ __forceinline__ int lds_byte(int r, int c) { const int st = (r >> 4) * 2 + (c >> 5), rr = r & 15, cc = c & 31, ob = rr * 64 + cc * 2; return st * 1024 + (ob ^ (((ob >> 9) & 1) << 5)); }
__host__ __device__ __forceinline__ void stage_rc(int b, int& R, int& C) { const int st = b / 1024, sb = b % 1024, swz = sb ^ (((sb >> 9) & 1) << 5); R = (st >> 1) * 16 + swz / 64; C = (st & 1) * 32 + (swz % 64) / 2; }
__host__ __device__ __forceinline__ int perm32(int rho) { const int n = rho >> 4, i = rho & 15; return 8 * (i >> 2) + 4 * n + (i & 3); }

struct Unit { int pm, pn; };
struct Gemm { const bf16_t* A; const bf16_t* Bt; int M, N, K; const unsigned* rowoff; };

struct StaticOrder {
    int nM, nN, nwg, G, c;
    __host__ __device__ void init(int M, int N, int G_, int c_) { nM = M / BM; nN = N / BM; nwg = nM * nN; G = G_; c = c_; }
    __host__ __device__ bool next(int i, Unit& u) const {
        const long L = (long)i * G + c; if (L >= nwg) return false;
        int wgid = (int)L; { const int q = nwg / NXCD, r = nwg % NXCD, xcd = wgid % NXCD, off = wgid / NXCD; wgid = (xcd < r ? xcd * (q + 1) : r * (q + 1) + (xcd - r) * q) + off; }
        const int nig = WGM * nN, gid = wgid / nig, fm = gid * WGM, gsz = (nM - fm) < WGM ? (nM - fm) : WGM;
        u.pm = fm + ((wgid % nig) % gsz); u.pn = (wgid % nig) / gsz; return true;
    }
    __device__ __forceinline__ void a_ready(const Unit&) const {}
    __device__ __forceinline__ void done(const Unit&) const {}
};

__device__ __forceinline__ unsigned cvt_pk_bf16(float lo, float hi) { unsigned r; asm volatile("v_cvt_pk_bf16_f32 %0, %1, %2" : "=v"(r) : "v"(lo), "v"(hi)); return r; }
typedef float f32x2 __attribute__((ext_vector_type(2)));

struct EpiBf16 {
    static constexpr bool PERM = true, AFTER_DRAIN = false;
    bf16_t* O; int ldc; int pnmask; float oscale;
    __device__ __forceinline__ void operator()(const f32x4 (&acc)[2][2][4][2], const Unit& u, int wr, int wc, int fr, int fq) const {
        const int row0 = u.pm * BM + wr * 64 + fr; const int col0 = (u.pn & pnmask) * BM + wc * 32 + 8 * fq;
#pragma unroll
        for (int ai = 0; ai < 2; ++ai)
#pragma unroll
            for (int m = 0; m < 4; ++m) { bf16_t* rowp = O + (size_t)(row0 + ai * HALF + m * 16) * ldc + col0;
#pragma unroll
                for (int bj = 0; bj < 2; ++bj) { const f32x4 v0 = acc[ai][bj][m][0] * oscale, v1 = acc[ai][bj][m][1] * oscale;
                    u32x4 w; w.x = cvt_pk_bf16(v0[0], v0[1]); w.y = cvt_pk_bf16(v0[2], v0[3]); w.z = cvt_pk_bf16(v1[0], v1[1]); w.w = cvt_pk_bf16(v1[2], v1[3]);
                    *(u32x4*)(rowp + bj * HALF) = w; } }
    }
};
struct EpiF8 {
    static constexpr bool PERM = true, AFTER_DRAIN = false;
    unsigned char* O; int ldc; int pnmask; float oscale;
    __device__ __forceinline__ void operator()(const f32x4 (&acc)[2][2][4][2], const Unit& u, int wr, int wc, int fr, int fq) const {
        const int row0 = u.pm * BM + wr * 64 + fr; const int col0 = (u.pn & pnmask) * BM + wc * 32 + 8 * fq;
        typedef int i32x2 __attribute__((ext_vector_type(2)));
#pragma unroll
        for (int ai = 0; ai < 2; ++ai)
#pragma unroll
            for (int m = 0; m < 4; ++m) { unsigned char* rowp = O + (size_t)(row0 + ai * HALF + m * 16) * ldc + col0;
#pragma unroll
                for (int bj = 0; bj < 2; ++bj) { const f32x4 lo4 = {-448.f, -448.f, -448.f, -448.f}, hi4 = {448.f, 448.f, 448.f, 448.f};
                    const f32x4 v0 = __builtin_elementwise_min(__builtin_elementwise_max(acc[ai][bj][m][0] * oscale, lo4), hi4), v1 = __builtin_elementwise_min(__builtin_elementwise_max(acc[ai][bj][m][1] * oscale, lo4), hi4);
                    int w0 = __builtin_amdgcn_cvt_pk_fp8_f32(v0[0], v0[1], 0, false); w0 = __builtin_amdgcn_cvt_pk_fp8_f32(v0[2], v0[3], w0, true);
                    int w1 = __builtin_amdgcn_cvt_pk_fp8_f32(v1[0], v1[1], 0, false); w1 = __builtin_amdgcn_cvt_pk_fp8_f32(v1[2], v1[3], w1, true);
                    *(i32x2*)(rowp + bj * HALF) = (i32x2){w0, w1}; } }
    }
};
template <bool F8OUT> struct EpiSwiGLU {
    static constexpr bool PERM = true, AFTER_DRAIN = false;
    bf16_t* O; int ldc; int pnmask; float oscale; float iscale;
    __device__ __forceinline__ static float silu_mul(float g, float u) { const float e = __builtin_amdgcn_exp2f(-1.4426950408889634f * g); return g * __builtin_amdgcn_rcpf(1.0f + e) * u; }
    __device__ __forceinline__ void operator()(const f32x4 (&acc)[2][2][4][2], const Unit& u, int wr, int wc, int fr, int fq) const {
        const int row0 = u.pm * BM + wr * 64 + fr; const int col0 = (u.pn & pnmask) * HALF + wc * 32 + 8 * fq;
#pragma unroll
        for (int ai = 0; ai < 2; ++ai)
#pragma unroll
            for (int m = 0; m < 4; ++m) { bf16_t* rowp = O + (size_t)(row0 + ai * HALF + m * 16) * ldc + col0;
                if constexpr (F8OUT) {
                    float h[8]; const float kt = -1.4426950408889634f * iscale, kd = 1.0f / (iscale * iscale * oscale);
#pragma unroll
                    for (int n = 0; n < 2; ++n) { const f32x4 G = acc[ai][0][m][n], U = acc[ai][1][m][n];
#pragma unroll
                        for (int hh = 0; hh < 2; ++hh) { const f32x2 gg = {G[2 * hh], G[2 * hh + 1]}, uu = {U[2 * hh], U[2 * hh + 1]};
                            const f32x2 t = gg * kt; f32x2 e; e.x = __builtin_amdgcn_exp2f(t.x); e.y = __builtin_amdgcn_exp2f(t.y);
                            const f32x2 d = e * kd + kd; f32x2 r; r.x = __builtin_amdgcn_rcpf(d.x); r.y = __builtin_amdgcn_rcpf(d.y);
                            const f32x2 p = (gg * uu) * r;
                            h[4 * n + 2 * hh] = __builtin_fminf(__builtin_fmaxf(p.x, -448.f), 448.f); h[4 * n + 2 * hh + 1] = __builtin_fminf(__builtin_fmaxf(p.y, -448.f), 448.f); } }
                    int w0 = __builtin_amdgcn_cvt_pk_fp8_f32(h[0], h[1], 0, false); w0 = __builtin_amdgcn_cvt_pk_fp8_f32(h[2], h[3], w0, true);
                    int w1 = __builtin_amdgcn_cvt_pk_fp8_f32(h[4], h[5], 0, false); w1 = __builtin_amdgcn_cvt_pk_fp8_f32(h[6], h[7], w1, true);
                    typedef int i32x2 __attribute__((ext_vector_type(2)));
                    *(i32x2*)((unsigned char*)O + (size_t)(row0 + ai * HALF + m * 16) * ldc + col0) = (i32x2){w0, w1};
                } else {
                const f32x4 g0 = acc[ai][0][m][0] * iscale, g1 = acc[ai][0][m][1] * iscale, u0 = acc[ai][1][m][0] * iscale, u1 = acc[ai][1][m][1] * iscale;
                u32x4 w; w.x = cvt_pk_bf16(silu_mul(g0[0], u0[0]), silu_mul(g0[1], u0[1])); w.y = cvt_pk_bf16(silu_mul(g0[2], u0[2]), silu_mul(g0[3], u0[3]));
                w.z = cvt_pk_bf16(silu_mul(g1[0], u1[0]), silu_mul(g1[1], u1[1])); w.w = cvt_pk_bf16(silu_mul(g1[2], u1[2]), silu_mul(g1[3], u1[3]));
                *(u32x4*)rowp = w; } }
    }
};
struct EpiF32 {
    static constexpr bool PERM = false, AFTER_DRAIN = false;
    float* O; int ldc;
    __device__ __forceinline__ void operator()(const f32x4 (&acc)[2][2][4][2], const Unit& u, int wr, int wc, int fr, int fq) const {
        const int row0 = u.pm * BM + wr * 64 + fr; const int col0 = u.pn * BM + wc * 32 + 4 * fq;
#pragma unroll
        for (int ai = 0; ai < 2; ++ai)
#pragma unroll
            for (int m = 0; m < 4; ++m) { float* rowp = O + (size_t)(row0 + ai * HALF + m * 16) * ldc + col0;
#pragma unroll
                for (int bj = 0; bj < 2; ++bj)
#pragma unroll
                    for (int n = 0; n < 2; ++n) *(f32x4*)(rowp + bj * HALF + n * 16) = acc[ai][bj][m][n]; }
    }
};
template <int NNL> struct GroupedOrder {
    int G, c;
    __device__ void init(int G_, int c_) { G = G_; c = c_; }
    __device__ bool next(int i, Unit& u) const {
        const int L = i * G + c; if (L >= 16 * 16 * NNL) return false;
        const int rnd = L >> 8, w = L & 255, x = w & 7, j = w >> 3;
        int e, rt, ct;
        if (NNL == 16) { e = rnd; rt = 4 * (x >> 1) + (j & 3); ct = 8 * (x & 1) + (j >> 2); }
        else           { e = 2 * rnd + (x >> 2); rt = 4 * (x & 3) + (j & 3); ct = j >> 2; }
        const int b = rt >> 1, half = rt & 1;
        u.pm = (b * 16 + e) * 2 + half; u.pn = e * NNL + ct; return true;
    }
    __device__ __forceinline__ void a_ready(const Unit&) const {}
    __device__ __forceinline__ void done(const Unit&) const {}
};
template <class Epi, class Sched, bool ALIGN_EPI = false, bool SP2 = false, bool F8 = false, bool GA = false>
__device__ __forceinline__ void gemm_phase(PG8_LAS unsigned char* lds, const Gemm g, const Sched& S, const Epi& E, const int wave0  ) {
    int tid = wave0 * 64 + ({ int l_; asm volatile("v_mbcnt_lo_u32_b32 %0, -1, 0\n\tv_mbcnt_hi_u32_b32 %0, -1, %0" : "=v"(l_)); l_; });
    const int wid = __builtin_amdgcn_readfirstlane(tid >> 6), lane = tid & 63, wr = wid >> 2, wc = wid & 3, fr = lane & 15, fq = lane >> 4;
    const int K = g.K, nt = K / BK;
    unsigned voffA[2], voffB[2];
#pragma unroll
    for (int i = 0; i < 2; ++i) { int R, C; stage_rc(tid * 16 + i * 8192, R, C); const int Rb = Epi::PERM ? ((R & ~31) + perm32(R & 31)) : R;
        voffA[i] = (unsigned)(R * K + C) * 2u; voffB[i] = (unsigned)(Rb * K + C) * 2u; }
    const size_t kstep = (size_t)(BK * 2);
    const size_t hstep = (size_t)HALF * K * 2;
    const size_t tstep = 2 * hstep;
    const size_t hstepA = GA ? 0 : hstep, tstepA = GA ? 0 : tstep;
    const unsigned ldsw = (unsigned)wid * 1024u;
    const int aoff = lds_byte(wr * 64 + fr, fq * 8), boff = lds_byte(wc * 32 + fr, fq * 8);
#define PG8_SA(b, h) (((b) * 2 + (h)) * HTB)
#define PG8_SB(b, h) ((4 + (b) * 2 + (h)) * HTB)
    const __amdgpu_buffer_rsrc_t rsA = __builtin_amdgcn_make_buffer_rsrc((void*)g.A, 0, 0x7FFFFFFF, 0x00020000), rsB = __builtin_amdgcn_make_buffer_rsrc((void*)g.Bt, 0, 0x7FFFFFFF, 0x00020000);
#define PG8_STAGE_X(rs, base0, bufoff, gbase, voff) do { const int so_ = (int)((const char*)(gbase) - (const char*)(base0)); _Pragma("unroll") for (int _i = 0; _i < 2; ++_i) \
        __builtin_amdgcn_raw_ptr_buffer_load_lds(rs, (PG8_LAS void*)(lds + (bufoff) + ldsw + _i * 8192), 16, (int)(voff)[_i], so_, 0, 0); } while (0)
#define PG8_STAGE_A(bufoff, gbase, voff) PG8_STAGE_X(rsA, g.A, bufoff, gbase, voff)
    static_assert(!GA || SP2, "gathered A rows: SP2 loop only");
    unsigned vg[2][2], vgn[2][2]; int gR[2]; unsigned gC[2]; constexpr int GA_LDS_OFF = 132096;
    const __amdgpu_buffer_rsrc_t rsR = __builtin_amdgcn_make_buffer_rsrc((void*)(GA ? (const void*)g.rowoff : (const void*)g.A), 0, 0x7FFFFFFF, 0x00020000);
    if constexpr (GA) {
#pragma unroll
        for (int i = 0; i < 2; ++i) { int R, C; stage_rc(tid * 16 + i * 8192, R, C); gR[i] = R; gC[i] = (unsigned)C * 2u; } }
#define PG8_STA(bufoff, h, nx, gbase) do { if constexpr (GA) { const int so_ = (int)((const char*)(gbase) - (const char*)g.A); _Pragma("unroll") for (int _i = 0; _i < 2; ++_i) \
            __builtin_amdgcn_raw_ptr_buffer_load_lds(rsA, (PG8_LAS void*)(lds + (bufoff) + ldsw + _i * 8192), 16, (int)((nx) ? vgn[h][_i] : vg[h][_i]), so_, 0, 0); } \
        else PG8_STAGE_X(rsA, g.A, bufoff, gbase, voffA); } while (0)
#define PG8_STAGE_B(bufoff, gbase, voff) PG8_STAGE_X(rsB, g.Bt, bufoff, gbase, voff)
#define PG8_LDA(dst, b, h) do { if constexpr (F8) { _Pragma("unroll") for (int m = 0; m < 4; ++m) { const i32x4 lo_ = *(const PG8_LAS i32x4*)(lds + PG8_SA(b, h) + aoff + m * 2048), hi_ = *(const PG8_LAS i32x4*)(lds + PG8_SA(b, h) + aoff + m * 2048 + 1024); \
            dst##8[m] = __builtin_shufflevector(lo_, hi_, 0, 1, 2, 3, 4, 5, 6, 7); } } \
        else { _Pragma("unroll") for (int m = 0; m < 4; ++m) _Pragma("unroll") for (int k = 0; k < 2; ++k) dst[m][k] = *(const PG8_LAS bf16x8*)(lds + PG8_SA(b, h) + aoff + m * 2048 + k * 1024); } } while (0)
#define PG8_LDB(dst, b, h) do { if constexpr (F8) { _Pragma("unroll") for (int n = 0; n < 2; ++n) { const i32x4 lo_ = *(const PG8_LAS i32x4*)(lds + PG8_SB(b, h) + boff + n * 2048), hi_ = *(const PG8_LAS i32x4*)(lds + PG8_SB(b, h) + boff + n * 2048 + 1024); \
            dst##8[n] = __builtin_shufflevector(lo_, hi_, 0, 1, 2, 3, 4, 5, 6, 7); } } \
        else { _Pragma("unroll") for (int n = 0; n < 2; ++n) _Pragma("unroll") for (int k = 0; k < 2; ++k) dst[n][k] = *(const PG8_LAS bf16x8*)(lds + PG8_SB(b, h) + boff + n * 2048 + k * 1024); } } while (0)
#define PG8_MMA(ai, bj, At, Bt) do { __builtin_amdgcn_s_setprio(1); \
        if constexpr (F8) { _Pragma("unroll") for (int m = 0; m < 4; ++m) _Pragma("unroll") for (int n = 0; n < 2; ++n) \
            asm volatile("v_mfma_f32_16x16x128_f8f6f4 %0, %1, %2, %0" : "+v"(acc[ai][bj][m][n]) : "v"(Bt##8[n]), "v"(At##8[m])); }   \
        else { _Pragma("unroll") for (int m = 0; m < 4; ++m) _Pragma("unroll") for (int n = 0; n < 2; ++n) _Pragma("unroll") for (int k = 0; k < 2; ++k) \
            acc[ai][bj][m][n] = __builtin_amdgcn_mfma_f32_16x16x32_bf16(Bt[n][k], At[m][k], acc[ai][bj][m][n], 0, 0, 0); } \
        __builtin_amdgcn_s_setprio(0); } while (0)
#define PG8_WAIT_V(n) asm volatile("s_waitcnt vmcnt(" #n ")" ::: "memory")
#define PG8_WAIT_L(n) asm volatile("s_waitcnt lgkmcnt(" #n ")" ::: "memory")
#define PG8_BAR __builtin_amdgcn_s_barrier()
#define PG8_SCHED __builtin_amdgcn_sched_barrier(0)
    Unit cur, nxt; int ui = 0;
    if (!S.next(0, cur)) return;
    f32x4 acc[2][2][4][2];
#pragma unroll
    for (int a = 0; a < 2; ++a)
#pragma unroll
        for (int b = 0; b < 2; ++b)
#pragma unroll
            for (int m = 0; m < 4; ++m)
#pragma unroll
                for (int n = 0; n < 2; ++n) acc[a][b][m][n] = (f32x4){0.f, 0.f, 0.f, 0.f};
    bf16x8 At[4][2], B0[2][2], B1[2][2]; i32x8 At8[4], B08[2], B18[2];
    const char* cA = (const char*)g.A + (size_t)cur.pm * tstepA; const char* cB = (const char*)g.Bt + (size_t)cur.pn * tstep;
    if constexpr (GA) {
#pragma unroll
        for (int h = 0; h < 2; ++h)
#pragma unroll
            for (int i = 0; i < 2; ++i) vg[h][i] = g.rowoff[cur.pm * BM + h * HALF + gR[i]] + gC[i]; }
    S.a_ready(cur);
    if constexpr (SP2) {
        PG8_STAGE_B(PG8_SB(0, 0), cB, voffB); PG8_STAGE_B(PG8_SB(0, 1), cB + hstep, voffB); PG8_STA(PG8_SA(0, 0), 0, false, cA); PG8_STA(PG8_SA(0, 1), 1, false, cA + hstepA);
        if (wr == 1) PG8_BAR;
        PG8_WAIT_V(2); PG8_BAR;
        PG8_STAGE_B(PG8_SB(1, 0), cB + kstep, voffB); PG8_STA(PG8_SA(1, 0), 0, false, cA + kstep); PG8_STAGE_B(PG8_SB(1, 1), cB + hstep + kstep, voffB);
        PG8_WAIT_V(6); PG8_BAR;
    } else {
        PG8_STAGE_B(PG8_SB(0, 0), cB, voffB); PG8_STAGE_A(PG8_SA(0, 0), cA, voffA); PG8_STAGE_B(PG8_SB(0, 1), cB + hstep, voffB); PG8_STAGE_A(PG8_SA(0, 1), cA + hstep, voffA);
        if (wr == 1) PG8_BAR;
        PG8_WAIT_V(4); PG8_BAR;
        PG8_STAGE_B(PG8_SB(1, 0), cB + kstep, voffB); PG8_STAGE_A(PG8_SA(1, 0), cA + kstep, voffA); PG8_STAGE_B(PG8_SB(1, 1), cB + hstep + kstep, voffB);
        PG8_WAIT_V(6); PG8_BAR;
    }
    for (;;) {
        const bool has_next = S.next(ui + 1, nxt);
        if constexpr (GA) { if (has_next && wid < 4)
            __builtin_amdgcn_raw_ptr_buffer_load_lds(rsR, (PG8_LAS void*)(lds + GA_LDS_OFF + (ui & 1) * 1024 + wid * 256), 4, tid * 4, nxt.pm * (BM * 4), 0, 0); }
        const char* nA = has_next ? (const char*)g.A + (size_t)nxt.pm * tstepA : cA; const char* nB = has_next ? (const char*)g.Bt + (size_t)nxt.pn * tstep : cB;
        for (int t = 0; t < nt; t += 2) {
            const bool last = (t == nt - 2);
            const char* a1 = cA + (size_t)(t + 1) * kstep;
            const char* a2 = last ? nA : cA + (size_t)(t + 2) * kstep; const char* b2 = last ? nB : cB + (size_t)(t + 2) * kstep;
            const char* a3 = a2 + kstep; const char* b3 = b2 + kstep;
            if (last && has_next) S.a_ready(nxt);
            if constexpr (GA) { if (last) {
#pragma unroll
                for (int h = 0; h < 2; ++h)
#pragma unroll
                    for (int i = 0; i < 2; ++i) vgn[h][i] = has_next ? *(const PG8_LAS unsigned*)(lds + GA_LDS_OFF + (ui & 1) * 1024 + (h * HALF + gR[i]) * 4) + gC[i] : vg[h][i]; } }
            if constexpr (SP2) {
            PG8_LDB(B0, 0, 0); PG8_LDB(B1, 0, 1); PG8_SCHED; PG8_LDA(At, 0, 0); PG8_STA(PG8_SA(1, 1), 1, false, a1 + hstepA);
            PG8_WAIT_V(8); PG8_WAIT_L(0); PG8_BAR; PG8_MMA(0, 0, At, B0); PG8_MMA(0, 1, At, B1); PG8_BAR; PG8_SCHED;
            PG8_LDA(At, 0, 1); PG8_STAGE_B(PG8_SB(0, 0), b2, voffB); PG8_STAGE_B(PG8_SB(0, 1), b2 + hstep, voffB); PG8_STA(PG8_SA(0, 0), 0, last, a2);
            PG8_WAIT_V(8); PG8_WAIT_L(0); PG8_BAR; PG8_MMA(1, 0, At, B0); PG8_MMA(1, 1, At, B1); PG8_BAR; PG8_SCHED;
            PG8_LDB(B0, 1, 0); PG8_LDB(B1, 1, 1); PG8_SCHED; PG8_LDA(At, 1, 0); PG8_STA(PG8_SA(0, 1), 1, last, a2 + hstepA);
            PG8_WAIT_V(8); PG8_WAIT_L(0); PG8_BAR; PG8_MMA(0, 0, At, B0); PG8_MMA(0, 1, At, B1); PG8_BAR; PG8_SCHED;
            PG8_LDA(At, 1, 1); PG8_STAGE_B(PG8_SB(1, 0), b3, voffB); PG8_STAGE_B(PG8_SB(1, 1), b3 + hstep, voffB); PG8_STA(PG8_SA(1, 0), 0, last, a3);
            PG8_WAIT_V(8); PG8_WAIT_L(0); PG8_BAR; PG8_MMA(1, 0, At, B0); PG8_MMA(1, 1, At, B1); PG8_BAR; PG8_SCHED;
            } else {
            PG8_LDB(B0, 0, 0); PG8_SCHED; PG8_LDA(At, 0, 0); PG8_STAGE_A(PG8_SA(1, 1), a1 + hstep, voffA);
            PG8_WAIT_L(8); PG8_BAR; PG8_WAIT_L(0); PG8_MMA(0, 0, At, B0); PG8_BAR; PG8_SCHED;
            PG8_LDB(B1, 0, 1); PG8_STAGE_B(PG8_SB(0, 0), b2, voffB);
            PG8_BAR; PG8_WAIT_L(0); PG8_MMA(0, 1, At, B1); PG8_BAR;
            PG8_LDA(At, 0, 1); PG8_STAGE_A(PG8_SA(0, 0), a2, voffA);
            PG8_BAR; PG8_WAIT_L(0); PG8_MMA(1, 0, At, B0); PG8_BAR; PG8_SCHED;
            PG8_STAGE_B(PG8_SB(0, 1), b2 + hstep, voffB);
            PG8_WAIT_V(6); PG8_BAR; PG8_MMA(1, 1, At, B1); PG8_BAR;
            PG8_LDB(B0, 1, 0); PG8_SCHED; PG8_LDA(At, 1, 0); PG8_STAGE_A(PG8_SA(0, 1), a2 + hstep, voffA);
            PG8_WAIT_L(8); PG8_BAR; PG8_WAIT_L(0); PG8_MMA(0, 0, At, B0); PG8_BAR; PG8_SCHED;
            PG8_LDB(B1, 1, 1); PG8_STAGE_B(PG8_SB(1, 0), b3, voffB);
            PG8_BAR; PG8_WAIT_L(0); PG8_MMA(0, 1, At, B1); PG8_BAR;
            PG8_LDA(At, 1, 1); PG8_STAGE_A(PG8_SA(1, 0), a3, voffA);
            PG8_BAR; PG8_WAIT_L(0); PG8_MMA(1, 0, At, B0); PG8_BAR; PG8_SCHED;
            PG8_STAGE_B(PG8_SB(1, 1), b3 + hstep, voffB);
            PG8_WAIT_V(6); PG8_BAR; PG8_MMA(1, 1, At, B1); PG8_BAR;
            }
        }
        if constexpr (F8) asm volatile("s_nop 15\n\ts_nop 15" ::: "memory");
        if constexpr (ALIGN_EPI) { if (wr == 0) PG8_BAR; }
        if constexpr (!Epi::AFTER_DRAIN) { E(acc, cur, wr, wc, fr, fq); S.done(cur); }
        if (!has_next) break;
#pragma unroll
        for (int a = 0; a < 2; ++a)
#pragma unroll
            for (int b = 0; b < 2; ++b)
#pragma unroll
                for (int m = 0; m < 4; ++m)
#pragma unroll
                    for (int n = 0; n < 2; ++n) acc[a][b][m][n] = (f32x4){0.f, 0.f, 0.f, 0.f};
        cur = nxt; cA = nA; cB = nB; ++ui;
        if constexpr (GA) {
#pragma unroll
            for (int h = 0; h < 2; ++h)
#pragma unroll
                for (int i = 0; i < 2; ++i) vg[h][i] = vgn[h][i]; }
        if constexpr (ALIGN_EPI) { if (wr == 1) PG8_BAR; }
    }
    PG8_WAIT_V(0);
    if constexpr (!ALIGN_EPI) { if (wr == 0) PG8_BAR; }
    PG8_BAR;
    if constexpr (Epi::AFTER_DRAIN) { E.fused(acc, cur, wr, wc, fr, fq, lds, wid, lane); S.done(cur); }
#undef PG8_SA
#undef PG8_SB
#undef PG8_STAGE_X
#undef PG8_STAGE_A
#undef PG8_STA
#undef PG8_STAGE_B
#undef PG8_LDA
#undef PG8_LDB
#undef PG8_MMA
#undef PG8_WAIT_V
#undef PG8_WAIT_L
#undef PG8_BAR
#undef PG8_SCHED
}
}

#define GAS __attribute__((address_space(1)))
#define LAS __attribute__((address_space(3)))
typedef unsigned short bf16_t;
typedef float f32x4 __attribute__((ext_vector_type(4)));
typedef float f32x2 __attribute__((ext_vector_type(2)));
typedef float f32x16 __attribute__((ext_vector_type(16)));
typedef unsigned u32x4 __attribute__((ext_vector_type(4)));
typedef unsigned u32x2 __attribute__((ext_vector_type(2)));
typedef short bf16x8 __attribute__((ext_vector_type(8)));
typedef short s16x4 __attribute__((ext_vector_type(4)));
typedef GAS unsigned gu32;
#define RLX_AGENT __ATOMIC_RELAXED, __HIP_MEMORY_SCOPE_AGENT
#define LDS_WAIT() asm volatile("s_waitcnt lgkmcnt(0)" ::: "memory")
#define VM_WAIT() asm volatile("s_waitcnt vmcnt(0)" ::: "memory")
__device__ __forceinline__ unsigned cvtpk(float lo, float hi) { unsigned r; asm volatile("v_cvt_pk_bf16_f32 %0, %1, %2" : "=v"(r) : "v"(lo), "v"(hi)); return r; }
__device__ __forceinline__ float bf_lo(unsigned w) { return __uint_as_float(w << 16); }
typedef __fp16 f16x2_t __attribute__((__vector_size__(2 * sizeof(__fp16))));
__device__ __forceinline__ unsigned pkh(float lo, float hi) { return __builtin_bit_cast(unsigned, __builtin_amdgcn_cvt_pkrtz(lo, hi)); }
__device__ __forceinline__ float h_lo(unsigned w) { return (float)__builtin_bit_cast(f16x2_t, w)[0]; }
__device__ __forceinline__ float h_hi(unsigned w) { return (float)__builtin_bit_cast(f16x2_t, w)[1]; }
__device__ __forceinline__ float bf_hi(unsigned w) { return __uint_as_float(w & 0xffff0000u); }
__device__ __forceinline__ float shx(float v, int mask, int lane) { return __int_as_float(__builtin_amdgcn_ds_bpermute((lane ^ mask) << 2, __float_as_int(v))); }
__device__ __forceinline__ int shup_i(int v, int o, int lane) { return __builtin_amdgcn_ds_bpermute(((lane - o) & 63) << 2, v); }
__device__ __forceinline__ float wave_sum(float v, int lane) {
#pragma unroll
    for (int o = 1; o < 64; o <<= 1) v += shx(v, o, lane);
    return v;
}

#ifndef REP_MASK
#define REP_MASK 0
#endif
#ifndef REP_N
#define REP_N 1
#endif
#define PH_REP(k) (1 + REP_N * (((REP_MASK) >> (k)) & 1))
template <int CTRL> __device__ __forceinline__ float dpp_mov(float v) { return __int_as_float(__builtin_amdgcn_update_dpp(0, __float_as_int(v), CTRL, 0xF, 0xF, true)); }
__device__ __forceinline__ float sum8_dpp(float v) { v += dpp_mov<0xB1>(v); v += dpp_mov<0x4E>(v); v += dpp_mov<0x141>(v); return v; }
__device__ __forceinline__ float swap16_add(float a, float b) { auto r = __builtin_amdgcn_permlane16_swap(__float_as_uint(a), __float_as_uint(b), false, false); return __uint_as_float(r[0]) + __uint_as_float(r[1]); }
__device__ __forceinline__ float swap32_add(float a, float b) { auto r = __builtin_amdgcn_permlane32_swap(__float_as_uint(a), __float_as_uint(b), false, false); return __uint_as_float(r[0]) + __uint_as_float(r[1]); }
__device__ __forceinline__ float wave_sum_v(float v) { v = sum8_dpp(v); v += dpp_mov<0x128>(v); v = swap16_add(v, v); return swap32_add(v, v); }
constexpr int DM = 2048, NB = 8, SEQ = 4096, T = NB * SEQ, HD = 128;
constexpr int AB_IN = 6144, C_IN = 3072, NE = 16, EH = 2048, CAP = 512, NSLOT = NB * NE * CAP;
constexpr float ALPHA = 1.4142135623730951f, LN_EPS = 1e-5f;
constexpr float SCALE = 0.088388347648318440f;
constexpr float LAM_INIT0 = 0.2f;
constexpr float WDN_SCALE = 128.f, HID_SCALE = 8.f, WGU_SCALE = 64.f, H2_SCALE = 4.f, YD_SCALE = 16.f;
constexpr float HIN1_SCALE = 16.f, WIN1_SCALE = 512.f;
constexpr float YO1_SCALE = 256.f;
constexpr float YATT_SCALE = 32.f, WOUT_SCALE = 128.f;

constexpr size_t MiB = 1u << 20;
constexpr size_t WS_CTL = 0, CTL_ZERO_BYTES = 1 * MiB;
constexpr size_t WS_MOD = 1 * MiB;
constexpr size_t WS_AFF = 2 * MiB;
constexpr size_t WS_IDX = 4 * MiB;
constexpr size_t WS_INVC = 5 * MiB;
constexpr size_t WS_INVG = 7 * MiB;
constexpr size_t WS_LSE = 9 * MiB;
constexpr size_t WS_WIN0 = 12 * MiB, WS_WIN1 = 36 * MiB, WS_WOUT0 = 48 * MiB, WS_WOUT1 = 56 * MiB;
constexpr size_t WS_WGU = 64 * MiB;
constexpr size_t WS_WDN = 320 * MiB;
constexpr size_t WS_HB = 448 * MiB;
constexpr size_t WS_R1 = 576 * MiB;
constexpr size_t WS_R2 = 960 * MiB;
constexpr size_t WS_R3 = 1344 * MiB;
constexpr size_t WS_X1 = 1600 * MiB;
constexpr size_t WS_END = 1856 * MiB;
constexpr int CW_BAR = 4096;
constexpr int CW_NRM = 8192;

constexpr int RING_BYTES = 131072;
constexpr int MISC_OFF = RING_BYTES + 320;
constexpr int LDS_BYTES = 147456;

#define XB_TMO      128
#define XB_XCNT(j)  (256  + 64 * (j))
#define XB_XSUB(j)  (1280 + 64 * (j))
#define XB_XGEN(j)  (2304 + 64 * (j))
#define XB_TOP      3328
#define XB_TOPGEN   3392
#define XCD_BAR_WORDS 3456
#define XB_SPIN_CAP (1u << 18)

__device__ __forceinline__ unsigned xb_ld(unsigned* p)              { return __hip_atomic_load(p, __ATOMIC_RELAXED, __HIP_MEMORY_SCOPE_AGENT); }
__device__ __forceinline__ unsigned xb_add(unsigned* p, unsigned v) { return __hip_atomic_fetch_add(p, v, __ATOMIC_RELAXED, __HIP_MEMORY_SCOPE_AGENT); }
__device__ __forceinline__ unsigned xb_xcc_id() { return (unsigned)__builtin_amdgcn_s_getreg((3 << 11) | 20) & 0xFu; }
#define XB_SPIN(cond, bar) do { unsigned _sp = 0; while (cond) { __builtin_amdgcn_s_sleep(1); \
    if ((++_sp & 255u) == 0u) { if (xb_ld(&(bar)[XB_TMO])) break; if (_sp > XB_SPIN_CAP) { atomicAdd(&(bar)[XB_TMO], 1u); break; } } } } while (0)

struct XcdBarrier {
    unsigned* bar; unsigned x;
    volatile LAS unsigned* st;
};

__device__ __forceinline__ XcdBarrier xcd_barrier_post(unsigned* bar, volatile LAS unsigned* st) {
    XcdBarrier b; b.bar = bar; b.x = xb_xcc_id(); b.st = st;
    if (threadIdx.x == 0) (void)xb_add(&bar[XB_XCNT(b.x)], 1u);
    return b;
}
__device__ __forceinline__ void xcd_barrier_complete(unsigned* bar, unsigned x, unsigned& nloc, unsigned& nx) {
    const unsigned G = gridDim.x * gridDim.y * gridDim.z;
    unsigned sum, cnt, mine, sp = 0u;
    for (;;) {
        sum = 0u; cnt = 0u; mine = 0u;
#pragma unroll
        for (unsigned j = 0; j < 16; ++j) { const unsigned c = xb_ld(&bar[XB_XCNT(j)]); sum += c; cnt += (c > 0u) ? 1u : 0u; mine = (j == x) ? c : mine; }
        if (sum == G) break;
        __builtin_amdgcn_s_sleep(1);
        if ((++sp & 255u) == 0u) { if (xb_ld(&bar[XB_TMO])) break; if (sp > XB_SPIN_CAP) { atomicAdd(&bar[XB_TMO], 1u); break; } }
    }
    nloc = mine > 0u ? mine : 1u; nx = cnt > 0u ? cnt : 1u;
}

__device__ __forceinline__ void xcd_barrier(const XcdBarrier& b, const bool leader  ) {
    asm volatile("s_waitcnt vmcnt(0)" ::: "memory");
    __syncthreads();
    if (leader) {
        unsigned* bar = b.bar;
        __builtin_amdgcn_s_waitcnt(0);
        unsigned nloc = b.st[0], nx = b.st[1];
        if (nloc == 0u) { xcd_barrier_complete(bar, b.x, nloc, nx); b.st[0] = nloc; b.st[1] = nx; }
        const unsigned old = xb_add(&bar[XB_XSUB(b.x)], 1u);
        const unsigned gen = old / nloc;
        if (old + 1u == (gen + 1u) * nloc) {
            __builtin_amdgcn_fence(__ATOMIC_RELEASE, "agent");
            asm volatile("s_waitcnt vmcnt(0)" ::: "memory");
            const unsigned og = xb_add(&bar[XB_TOP], 1u);
            const unsigned tg = og / nx;
            if (og + 1u == (tg + 1u) * nx) xb_add(&bar[XB_TOPGEN], 1u);
            else XB_SPIN(xb_ld(&bar[XB_TOPGEN]) == tg, bar);
            __builtin_amdgcn_fence(__ATOMIC_ACQUIRE, "agent");
            xb_add(&bar[XB_XGEN(b.x)], 1u);
            asm volatile("s_waitcnt vmcnt(0)" ::: "memory");
        } else {
            XB_SPIN(xb_ld(&bar[XB_XGEN(b.x)]) == gen, bar);
            __builtin_amdgcn_fence(__ATOMIC_ACQUIRE, "agent");
            asm volatile("s_waitcnt vmcnt(0)" ::: "memory");
        }
    }
    __syncthreads();
}

namespace att {
constexpr int KVBLK = 64;
constexpr int SHM_V = KVBLK * 128 * 2, SHM_K = KVBLK * 128 * 2, SHM_ATTN = 3 * (SHM_V + SHM_K) + 8 * 64 * 4;
constexpr float THR = 8.f;
#define KSWZ(row, colB) ((row) * 256 + ((colB) ^ (((row) & 7) << 4)))
#define SBAR() __builtin_amdgcn_sched_barrier(0)
__device__ __forceinline__ int crow(int r, int hi) { return (r & 3) + 8 * (r >> 2) + 4 * hi; }
constexpr float THR2 = 8.f * 1.4426950408889634f;
__device__ __forceinline__ void partialSM(f32x16& p0, f32x16& p1, float& m_run, float& alpha) {
  float pmax = fmaxf(fmaxf(p0[0], p0[1]), p0[2]);
#pragma unroll
  for (int r = 3; r < 15; r += 2) pmax = fmaxf(fmaxf(pmax, p0[r]), p0[r + 1]);
  pmax = fmaxf(fmaxf(pmax, p0[15]), p1[0]);
#pragma unroll
  for (int r = 1; r < 15; r += 2) pmax = fmaxf(fmaxf(pmax, p1[r]), p1[r + 1]);
  pmax = fmaxf(pmax, p1[15]);
  { auto rr = __builtin_amdgcn_permlane32_swap(__float_as_uint(pmax), __float_as_uint(pmax), false, false);
    pmax = fmaxf(__uint_as_float(rr[0]), __uint_as_float(rr[1])); }
  if (__builtin_expect(__all(pmax <= THR2), 1)) { alpha = 1.f; }
  else { const float d = fmaxf(pmax, 0.f); alpha = __builtin_amdgcn_exp2f(-d); m_run += d;
#pragma unroll
    for (int r = 0; r < 16; ++r) { p0[r] -= d; p1[r] -= d; } }
#pragma unroll
  for (int r = 0; r < 16; ++r) p0[r] = __builtin_amdgcn_exp2f(p0[r]);
}
__device__ __forceinline__ void finishSM(f32x16& p0, f32x16& p1, float alpha, float& l_reg, bf16x8& pa0, bf16x8& pa1, bf16x8& pa2, bf16x8& pa3) {
#pragma unroll
  for (int r = 0; r < 16; ++r) p1[r] = __builtin_amdgcn_exp2f(p1[r]);
  float ps = 0;
#pragma unroll
  for (int r = 0; r < 16; ++r) ps += p0[r];
#pragma unroll
  for (int r = 0; r < 16; ++r) ps += p1[r];
  { auto rr = __builtin_amdgcn_permlane32_swap(__float_as_uint(ps), __float_as_uint(ps), false, false);
    ps = __uint_as_float(rr[0]) + __uint_as_float(rr[1]); }
  l_reg = l_reg * alpha + ps;
#define PK4(P, BASE, OUT) do { unsigned a0 = cvtpk(P[BASE + 0], P[BASE + 1]), a1 = cvtpk(P[BASE + 2], P[BASE + 3]);   \
    unsigned b0 = cvtpk(P[BASE + 4], P[BASE + 5]), b1 = cvtpk(P[BASE + 6], P[BASE + 7]);                              \
    auto r0 = __builtin_amdgcn_permlane32_swap(a0, b0, false, false); auto r1 = __builtin_amdgcn_permlane32_swap(a1, b1, false, false); \
    u32x4 w = {r0[0], r1[0], r0[1], r1[1]}; OUT = __builtin_bit_cast(bf16x8, w); } while (0)
  PK4(p0, 0, pa0); PK4(p0, 8, pa1); PK4(p1, 0, pa2); PK4(p1, 8, pa3);
#undef PK4
}
template <bool BANDED>
__device__ __forceinline__ void qkt(f32x16& p0, f32x16& p1, const LAS char* Ks, const bf16x8* qr, int r32, int hi, float base, float nsl2, float radius, float m_run, int side) {
  if (!BANDED && side != 0) {
    const float sa = nsl2 * (float)side, t = fmaf(sa, base, -m_run), na = -sa;
#pragma unroll
    for (int r = 0; r < 16; ++r) { const float c = (float)((r & 3) + 8 * (r >> 2)); p0[r] = fmaf(na, c, t); p1[r] = fmaf(na, c + 32.f, t); }
  } else {
#pragma unroll
    for (int r = 0; r < 16; ++r) { const float c = (float)((r & 3) + 8 * (r >> 2));
      const float a0 = __builtin_fabsf(base - c), a1 = __builtin_fabsf(base - (c + 32.f));
      float v0 = fmaf(a0, nsl2, -m_run), v1 = fmaf(a1, nsl2, -m_run);
      if (BANDED) { v0 = a0 > radius ? -INFINITY : v0; v1 = a1 > radius ? -INFINITY : v1; }
      p0[r] = v0; p1[r] = v1; }
  }
#pragma unroll
  for (int d0 = 0; d0 < 8; ++d0) { const int cb = (d0 * 16 + hi * 8) * 2;
    const bf16x8 b0 = *(const LAS bf16x8*)(Ks + KSWZ(r32, cb));
    const bf16x8 b1 = *(const LAS bf16x8*)(Ks + KSWZ(32 + r32, cb));
    p0 = __builtin_amdgcn_mfma_f32_32x32x16_bf16(b0, qr[d0], p0, 0, 0, 0);
    p1 = __builtin_amdgcn_mfma_f32_32x32x16_bf16(b1, qr[d0], p1, 0, 0, 0); }
}
__device__ __forceinline__ int v_st(int k, int c) { const int kk = (k & ~0xC) | ((k & 4) << 1) | ((k & 8) >> 1); return ((kk >> 3) * 4 + (c >> 5)) * 512 + ((kk & 7) * 32 + (c & 31)) * 2; }
__device__ __forceinline__ int v_rd_base(int lane) { return ((lane & 3) << 3) | (((lane >> 2) & 3) << 6) | (((lane >> 4) & 1) << 5) | (((lane >> 5) & 1) << 8); }
constexpr int v_rd_off(int d0, int ks, int half) { return d0 * 512 + ks * 4096 + half * 2048; }
template <int OFF> __device__ __forceinline__ s16x4 tr_read(int vb) {
  s16x4 r; asm volatile("ds_read_b64_tr_b16 %0, %1 offset:%2" : "=&v"(r) : "v"(vb), "i"(OFF) : "memory"); return r;
}
template <int D0> __device__ __forceinline__ void pv_one(f32x16& od, int vb, bf16x8 pa0, bf16x8 pa1, bf16x8 pa2, bf16x8 pa3) {
  const s16x4 l0 = tr_read<v_rd_off(D0, 0, 0)>(vb), h0 = tr_read<v_rd_off(D0, 0, 1)>(vb), l1 = tr_read<v_rd_off(D0, 1, 0)>(vb), h1 = tr_read<v_rd_off(D0, 1, 1)>(vb);
  const s16x4 l2 = tr_read<v_rd_off(D0, 2, 0)>(vb), h2 = tr_read<v_rd_off(D0, 2, 1)>(vb), l3 = tr_read<v_rd_off(D0, 3, 0)>(vb), h3 = tr_read<v_rd_off(D0, 3, 1)>(vb);
  asm volatile("s_waitcnt lgkmcnt(0)" ::: "memory"); SBAR();
#define PK(L, H) (bf16x8){L[0], L[1], L[2], L[3], H[0], H[1], H[2], H[3]}
  od = __builtin_amdgcn_mfma_f32_32x32x16_bf16(pa0, PK(l0, h0), od, 0, 0, 0);
  od = __builtin_amdgcn_mfma_f32_32x32x16_bf16(pa1, PK(l1, h1), od, 0, 0, 0);
  od = __builtin_amdgcn_mfma_f32_32x32x16_bf16(pa2, PK(l2, h2), od, 0, 0, 0);
  od = __builtin_amdgcn_mfma_f32_32x32x16_bf16(pa3, PK(l3, h3), od, 0, 0, 0);
#undef PK
}
__device__ __forceinline__ void pv_d0(f32x16* o, int vb, bf16x8 pa0, bf16x8 pa1, bf16x8 pa2, bf16x8 pa3) {
  pv_one<0>(o[0], vb, pa0, pa1, pa2, pa3); pv_one<1>(o[1], vb, pa0, pa1, pa2, pa3); pv_one<2>(o[2], vb, pa0, pa1, pa2, pa3); pv_one<3>(o[3], vb, pa0, pa1, pa2, pa3);
}

template <bool BANDED>
__device__ __forceinline__ void attn_unit(const bf16_t* __restrict__ Qb, int ldq, const bf16_t* __restrict__ Kt, const bf16_t* __restrict__ Vt, int ldk,
                                          bf16_t* __restrict__ Ob, int ldo, float* __restrict__ Lb, int ldl,
                                          int qrel, int NT, float nsl2, float radius, float sink2, LAS char* lds, const int wave0, const bool o8 = false) {
  int tid = wave0 * 64 + ({ int l_; asm volatile("v_mbcnt_lo_u32_b32 %0, -1, 0\n\tv_mbcnt_hi_u32_b32 %0, -1, %0" : "=v"(l_)); l_; });
  const int wid = tid >> 6, lane = tid & 63, r32 = lane & 31, hi = lane >> 5;
  const int wu = __builtin_amdgcn_readfirstlane(wid);
  LAS float* ws = (LAS float*)(lds + 3 * 32768) + wid * 64; LAS float* li_l = ws; LAS float* al_l = ws + 32;
  __syncthreads();
  const __amdgpu_buffer_rsrc_t krs = __builtin_amdgcn_make_buffer_rsrc((void*)Kt, 0, 0x7FFFFFFF, 0x00020000), vrs = __builtin_amdgcn_make_buffer_rsrc((void*)Vt, 0, 0x7FFFFFFF, 0x00020000);
  int koffD[2], voffD[2];
#pragma unroll
  for (int i = 0; i < 2; ++i) { const int row = (i * 8 + wid) * 4 + (lane >> 4), cp = lane & 15; koffD[i] = (row * ldk) * 2 + ((cp ^ (row & 7)) << 4);
    const int s_ = (i * 8 + wid) * 2 + (lane >> 5), kk = (s_ >> 2) * 8 + ((lane & 31) >> 2), c = (s_ & 3) * 32 + (lane & 3) * 8, k = (kk & ~0xC) | ((kk & 4) << 1) | ((kk & 8) >> 1);
    voffD[i] = (k * ldk + c) * 2; }
  const int tstep = 128 * ldk;
#define DISSUE(j) do { const int o_ = (j) * tstep; LAS char* sb_ = lds + ((j) % 3) * 32768 + wu * 1024; \
    __builtin_amdgcn_raw_ptr_buffer_load_lds(vrs, (LAS void*)(sb_), 16, voffD[0], o_, 0, 0); __builtin_amdgcn_raw_ptr_buffer_load_lds(vrs, (LAS void*)(sb_ + 8192), 16, voffD[1], o_, 0, 0); \
    __builtin_amdgcn_raw_ptr_buffer_load_lds(krs, (LAS void*)(sb_ + 16384), 16, koffD[0], o_, 0, 0); __builtin_amdgcn_raw_ptr_buffer_load_lds(krs, (LAS void*)(sb_ + 16384 + 8192), 16, koffD[1], o_, 0, 0); } while (0)
#define BAR() asm volatile("s_waitcnt lgkmcnt(0)\n\ts_barrier" ::: "memory")
#define WAITBAR(more) do { if (more) asm volatile("s_waitcnt vmcnt(4) lgkmcnt(0)\n\ts_barrier" ::: "memory"); else asm volatile("s_waitcnt vmcnt(0) lgkmcnt(0)\n\ts_barrier" ::: "memory"); } while (0)
  DISSUE(0); DISSUE(1);
  float m_reg = 0.f, l_reg = 0; f32x16 o[4] = {}; bf16x8 qr[8];
  { const unsigned qoff = (unsigned)((wid * 32 + r32) * ldq + hi * 8) * 2u;
#pragma unroll
    for (int d0 = 0; d0 < 8; ++d0) qr[d0] = *(const bf16x8*)((const char*)Qb + (qoff + d0 * 32)); }
  const int vb0 = (int)(unsigned)(uintptr_t)lds + v_rd_base(lane);
  const float qb_f = (float)(qrel + wid * 32 + r32 - 4 * hi);
#define RESC(a) do { if (__any((a) < 1.f)) { if (hi == 0) al_l[r32] = (a); asm volatile("s_waitcnt lgkmcnt(0)" ::: "memory"); \
    _Pragma("unroll") for (int d = 0; d < 4; ++d) _Pragma("unroll") for (int r = 0; r < 16; ++r) o[d][r] *= al_l[crow(r, hi)]; } } while (0)
#define SLOT(j) ({ int so_ = ((j) % 3) * 32768; asm volatile("" : "+s"(so_)); so_; })
#define SIDE(j) ((64 * (j) + 63 <= qw_) ? 1 : ((64 * (j) >= qw_ + 31) ? -1 : 0))
#define QKT(P0, P1, j) qkt<BANDED>(P0, P1, lds + SLOT(j) + 16384, qr, r32, hi, qb_f - (float)(64 * (j)), nsl2, radius, m_reg, SIDE(j))
#define PV(j) pv_d0(o, vb0 + SLOT(j), pa0, pa1, pa2, pa3)
  f32x16 pA0, pA1, pB0, pB1; float alA, alB; bf16x8 pa0, pa1, pa2, pa3;
  const int qw_ = __builtin_amdgcn_readfirstlane(qrel + 32 * wid), ri_ = (int)radius;
#define NEED(j) (!BANDED || ((64 * (j) + 63 >= qw_ - ri_) && (64 * (j) <= qw_ + 31 + ri_)))
#define QKTN(P0, P1, j, need) do { if (need) QKT(P0, P1, j); } while (0)
#define PSM(P0, P1, AL, need) do { if (need) partialSM(P0, P1, m_reg, AL); else AL = 1.f; } while (0)
#define FSM(P0, P1, AL, need) do { if (need) finishSM(P0, P1, AL, l_reg, pa0, pa1, pa2, pa3); } while (0)
  asm volatile("s_waitcnt vmcnt(0) lgkmcnt(0)\n\ts_barrier" ::: "memory");
  { const bool n0 = NEED(0); QKTN(pA0, pA1, 0, n0); PSM(pA0, pA1, alA, n0); }
  if (2 < NT) DISSUE(2);
  for (int j = 1; j + 1 < NT; j += 2) {
    const bool nP = NEED(j - 1), nC = NEED(j), nN = NEED(j + 1);
    SBAR(); QKTN(pB0, pB1, j, nC);
    FSM(pA0, pA1, alA, nP); SBAR();
    if (nP) PV(j - 1); PSM(pB0, pB1, alB, nC);
    BAR(); if (j + 2 < NT) DISSUE(j + 2);
    if (nC) RESC(alB); WAITBAR(j + 2 < NT);
    SBAR(); QKTN(pA0, pA1, j + 1, nN);
    FSM(pB0, pB1, alB, nC); SBAR();
    if (nC) PV(j); PSM(pA0, pA1, alA, nN);
    BAR(); if (j + 3 < NT) DISSUE(j + 3);
    if (nN) RESC(alA); WAITBAR(j + 3 < NT);
  }
  { const bool nP = NEED(NT - 2), nC = NEED(NT - 1);
    SBAR(); QKTN(pB0, pB1, NT - 1, nC);
    FSM(pA0, pA1, alA, nP); SBAR();
    if (nP) PV(NT - 2); PSM(pB0, pB1, alB, nC);
    if (nC) { RESC(alB);
      finishSM(pB0, pB1, alB, l_reg, pa0, pa1, pa2, pa3); SBAR();
      PV(NT - 1); } }
#undef PSM
#undef FSM
#undef QKTN
#undef DISSUE
#undef BAR
#undef WAITBAR
#undef PV
#undef SLOT
#undef SIDE
  { const float mf = fmaxf(m_reg, sink2); const float a = __builtin_amdgcn_exp2f(m_reg - mf); const float lnew = l_reg * a + __builtin_amdgcn_exp2f(sink2 - mf);
    if (hi == 0) li_l[r32] = a / lnew;
    if (Lb != nullptr && hi == 0) Lb[(wid * 32 + r32) * ldl] = (m_reg + __log2f(l_reg)) * 0.69314718055994531f; }
  asm volatile("s_waitcnt lgkmcnt(0)" ::: "memory");
  float rli[16];
#pragma unroll
  for (int r = 0; r < 16; ++r) rli[r] = li_l[crow(r, hi)];
  __syncthreads();
  if (o8) { LAS char* st = lds + wid * 8448;
#pragma unroll
    for (int r = 0; r < 16; ++r) { const int orow = crow(r, hi); const float sc = rli[r] * YATT_SCALE;
#pragma unroll
      for (int d0 = 0; d0 < 4; ++d0) { const float x = __builtin_fminf(__builtin_fmaxf(o[d0][r] * sc, -448.f), 448.f);
        *(LAS unsigned char*)(st + orow * 136 + d0 * 32 + r32) = (unsigned char)(__builtin_amdgcn_cvt_pk_fp8_f32(x, 0.f, 0, false) & 0xff); } }
    asm volatile("s_waitcnt lgkmcnt(0)" ::: "memory");
    const int rr = lane >> 3, ch = lane & 7;
#pragma unroll
    for (int t = 0; t < 4; ++t) { const int row = 8 * t + rr; const u32x2 lo = *(const LAS u32x2*)(st + row * 136 + ch * 16), hi2 = *(const LAS u32x2*)(st + row * 136 + ch * 16 + 8);
      *(u32x4*)((char*)Ob + ((size_t)(unsigned)((wid * 32 + row) * ldo)) * 2 + ch * 16) = (u32x4){lo.x, lo.y, hi2.x, hi2.y}; } }
  else { LAS char* st = lds + wid * 8448;
#pragma unroll
    for (int r = 0; r < 16; ++r) { const int orow = crow(r, hi);
#pragma unroll
      for (int d0 = 0; d0 < 4; ++d0) *(LAS unsigned short*)(st + orow * 264 + (d0 * 32 + r32) * 2) = (unsigned short)(cvtpk(o[d0][r] * rli[r], 0.f) & 0xffffu); }
    asm volatile("s_waitcnt lgkmcnt(0)" ::: "memory");
    const int rr = lane >> 4, ch = lane & 15;
#pragma unroll
    for (int t = 0; t < 8; ++t) { const int row = 4 * t + rr; const u32x2 lo = *(const LAS u32x2*)(st + row * 264 + ch * 16), hi2 = *(const LAS u32x2*)(st + row * 264 + ch * 16 + 8);
      *(u32x4*)((char*)Ob + ((size_t)(unsigned)((wid * 32 + row) * ldo + ch * 8)) * 2) = (u32x4){lo.x, lo.y, hi2.x, hi2.y}; } }
#undef RESC
#undef QKT
#undef NEED
}

__device__ __forceinline__ void softmax_tile(f32x16& p0, f32x16& p1, float& m_run, float& alpha, float& l_reg, bf16x8& pa0, bf16x8& pa1, bf16x8& pa2, bf16x8& pa3) {
  partialSM(p0, p1, m_run, alpha); finishSM(p0, p1, alpha, l_reg, pa0, pa1, pa2, pa3);
}
__device__ __forceinline__ void attn_unit256(const bf16_t* __restrict__ Qb, int ldq, const bf16_t* __restrict__ Kt, const bf16_t* __restrict__ Vt, int ldk,
                                             bf16_t* __restrict__ Ob, int ldo, int qrel, int NT, float nsl2, LAS char* lds, const int wave0) {
  int tid = wave0 * 64 + ({ int l_; asm volatile("v_mbcnt_lo_u32_b32 %0, -1, 0\n\tv_mbcnt_hi_u32_b32 %0, -1, %0" : "=v"(l_)); l_; });
  const int wid = tid >> 6, lane = tid & 63, r32 = lane & 31, hi = lane >> 5;
  const int wu = __builtin_amdgcn_readfirstlane(wid);
  constexpr int KS = 0, VS = 32768, WSO = 98304;
  LAS float* ws = (LAS float*)(lds + WSO) + wid * 64; LAS float* li_l = ws; LAS float* al_l = ws + 32;
  __syncthreads();
  const __amdgpu_buffer_rsrc_t krs = __builtin_amdgcn_make_buffer_rsrc((void*)Kt, 0, 0x7FFFFFFF, 0x00020000), vrs = __builtin_amdgcn_make_buffer_rsrc((void*)Vt, 0, 0x7FFFFFFF, 0x00020000);
  int koffD[2], voffD[2];
#pragma unroll
  for (int i = 0; i < 2; ++i) { const int row = (i * 8 + wid) * 4 + (lane >> 4), cp = lane & 15; koffD[i] = (row * ldk) * 2 + ((cp ^ (row & 7)) << 4);
    const int s_ = (i * 8 + wid) * 2 + (lane >> 5), kk = (s_ >> 2) * 8 + ((lane & 31) >> 2), c = (s_ & 3) * 32 + (lane & 3) * 8, k = (kk & ~0xC) | ((kk & 4) << 1) | ((kk & 8) >> 1);
    voffD[i] = (k * ldk + c) * 2; }
  const int tstep = 128 * ldk;
#define ISSUEK(j) do { const int o_ = (j) * tstep; LAS char* sb_ = lds + KS + ((j) & 1) * 16384 + wu * 1024; \
    __builtin_amdgcn_raw_ptr_buffer_load_lds(krs, (LAS void*)(sb_), 16, koffD[0], o_, 0, 0); __builtin_amdgcn_raw_ptr_buffer_load_lds(krs, (LAS void*)(sb_ + 8192), 16, koffD[1], o_, 0, 0); } while (0)
#define ISSUEV(j) do { const int o_ = (j) * tstep; LAS char* sb_ = lds + VS + ((j) & 1) * 32768 + wu * 1024; \
    __builtin_amdgcn_raw_ptr_buffer_load_lds(vrs, (LAS void*)(sb_), 16, voffD[0], o_, 0, 0); __builtin_amdgcn_raw_ptr_buffer_load_lds(vrs, (LAS void*)(sb_ + 8192), 16, voffD[1], o_, 0, 0); \
    __builtin_amdgcn_raw_ptr_buffer_load_lds(vrs, (LAS void*)(sb_ + 16384), 16, voffD[0] + 256, o_, 0, 0); __builtin_amdgcn_raw_ptr_buffer_load_lds(vrs, (LAS void*)(sb_ + 16384 + 8192), 16, voffD[1] + 256, o_, 0, 0); } while (0)
  ISSUEK(0); ISSUEV(0);
  float m_reg = 0.f, l_reg = 0.f, al = 1.f; f32x16 o[8] = {}; bf16x8 qr[8];
  { const unsigned qoff = (unsigned)((wid * 32 + r32) * ldq + hi * 8) * 2u;
#pragma unroll
    for (int d0 = 0; d0 < 8; ++d0) qr[d0] = *(const bf16x8*)((const char*)Qb + (qoff + d0 * 32)); }
  const int vb0 = (int)(unsigned)(uintptr_t)lds + VS + v_rd_base(lane);
  const float qb_f = (float)(qrel + wid * 32 + r32 - 4 * hi);
  const int qw_ = __builtin_amdgcn_readfirstlane(qrel + 32 * wid);
  f32x16 p0, p1; bf16x8 pa0, pa1, pa2, pa3;
#define RESC8(a) do { if (__any((a) < 1.f)) { if (hi == 0) al_l[r32] = (a); asm volatile("s_waitcnt lgkmcnt(0)" ::: "memory"); \
    _Pragma("unroll") for (int d = 0; d < 8; ++d) _Pragma("unroll") for (int r = 0; r < 16; ++r) o[d][r] *= al_l[crow(r, hi)]; } } while (0)
#define OPQ(x) ({ int so_ = __builtin_amdgcn_readfirstlane(x); asm volatile("" : "+s"(so_)); so_; })
#define QKSM(j) do { qkt<false>(p0, p1, lds + KS + OPQ(((j) & 1) * 16384), qr, r32, hi, qb_f - (float)(64 * (j)), nsl2, 0.f, m_reg, ((64 * (j) + 63 <= qw_) ? 1 : ((64 * (j) >= qw_ + 31) ? -1 : 0))); \
    softmax_tile(p0, p1, m_reg, al, l_reg, pa0, pa1, pa2, pa3); } while (0)
#define PV8(j) do { const int vb_ = vb0 + OPQ(((j) & 1) * 32768); RESC8(al); pv_d0(o, vb_, pa0, pa1, pa2, pa3); pv_d0(o + 4, vb_ + 16384, pa0, pa1, pa2, pa3); } while (0)
  asm volatile("s_waitcnt vmcnt(0) lgkmcnt(0)\n\ts_barrier" ::: "memory");
  for (int j = 0; j < NT; ++j) {
    if (j > 0) asm volatile("s_waitcnt vmcnt(0) lgkmcnt(0)\n\ts_barrier" ::: "memory");
    if (j + 1 < NT) { ISSUEK(j + 1); ISSUEV(j + 1); }
    QKSM(j); PV8(j);
  }
  if (hi == 0) li_l[r32] = 1.0f / l_reg;
  asm volatile("s_waitcnt lgkmcnt(0)" ::: "memory");
  float rli[16];
#pragma unroll
  for (int r = 0; r < 16; ++r) rli[r] = li_l[crow(r, hi)];
#pragma unroll
  for (int half = 0; half < 2; ++half) {
    __syncthreads();
    LAS char* st = lds + wid * 8448;
#pragma unroll
    for (int r = 0; r < 16; ++r) { const int orow = crow(r, hi);
#pragma unroll
      for (int d0 = 0; d0 < 4; ++d0) *(LAS unsigned short*)(st + orow * 264 + (d0 * 32 + r32) * 2) = (unsigned short)(cvtpk(o[half * 4 + d0][r] * rli[r], 0.f) & 0xffffu); }
    asm volatile("s_waitcnt lgkmcnt(0)" ::: "memory");
    const int rr = lane >> 4, ch = lane & 15;
#pragma unroll
    for (int t = 0; t < 8; ++t) { const int row = 4 * t + rr; const u32x2 lo = *(const LAS u32x2*)(st + row * 264 + ch * 16), hi2 = *(const LAS u32x2*)(st + row * 264 + ch * 16 + 8);
      *(u32x4*)((char*)Ob + ((size_t)(unsigned)((wid * 32 + row) * ldo + half * 128 + ch * 8)) * 2) = (u32x4){lo.x, lo.y, hi2.x, hi2.y}; }
  }
#undef ISSUEK
#undef ISSUEV
#undef RESC8
#undef OPQ
#undef QKSM
#undef PV8
}
}

struct Args { const float* in[17]; float* out; unsigned char* ws; int ph_lo, ph_hi; };
enum { IN_X = 0, IN_C, IN_ADAW, IN_ADAB, IN_LNG, IN_LNB, IN_ABWIN, IN_ABWOUT, IN_DLAM, IN_SUBLN, IN_CWIN, IN_CWOUT, IN_CSINK, IN_ROUTER, IN_WGATE, IN_WUP, IN_WDOWN };

__device__ __forceinline__ void transpose_item(const float* __restrict__ W, int ldn, int K, int k0, int n0, bf16_t* __restrict__ dst, int drow0, float wscale, LAS float* scr, int lane) {
    f32x4 v[8];
#pragma unroll
    for (int i = 0; i < 8; ++i) v[i] = *(const f32x4*)(W + (size_t)(k0 + 8 * i + (lane >> 3)) * ldn + n0 + 4 * (lane & 7));
#pragma unroll
    for (int i = 0; i < 8; ++i) { LAS float* d = scr + (8 * i + (lane >> 3)) * 33 + 4 * (lane & 7); d[0] = v[i][0] * wscale; d[1] = v[i][1] * wscale; d[2] = v[i][2] * wscale; d[3] = v[i][3] * wscale; }
    LDS_WAIT(); asm volatile("" ::: "memory");
    const int c = lane & 7;
#pragma unroll
    for (int j = 0; j < 4; ++j) { const int n = (lane >> 3) + 8 * j; const LAS float* s = scr + (8 * c) * 33 + n;
        u32x4 o; o.x = cvtpk(s[0 * 33], s[1 * 33]); o.y = cvtpk(s[2 * 33], s[3 * 33]); o.z = cvtpk(s[4 * 33], s[5 * 33]); o.w = cvtpk(s[6 * 33], s[7 * 33]);
        *(u32x4*)(dst + (size_t)(drow0 + n) * K + k0 + 8 * c) = o; }
    LDS_WAIT(); asm volatile("" ::: "memory");
}
__device__ __forceinline__ void transpose_item_f8(const float* __restrict__ W, int ldn, int K, int k0, int n0, unsigned char* __restrict__ dst, int drow0, float wscale, LAS float* scr, int lane) {
    f32x4 v[8];
#pragma unroll
    for (int i = 0; i < 8; ++i) v[i] = *(const f32x4*)(W + (size_t)(k0 + 8 * i + (lane >> 3)) * ldn + n0 + 4 * (lane & 7));
#pragma unroll
    for (int i = 0; i < 8; ++i) { LAS float* d = scr + (8 * i + (lane >> 3)) * 33 + 4 * (lane & 7); d[0] = v[i][0] * wscale; d[1] = v[i][1] * wscale; d[2] = v[i][2] * wscale; d[3] = v[i][3] * wscale; }
    LDS_WAIT(); asm volatile("" ::: "memory");
    const int c = lane & 3;
#pragma unroll
    for (int j = 0; j < 2; ++j) { const int n = (lane >> 2) + 16 * j; const LAS float* s = scr + (16 * c) * 33 + n;
        int w[4];
#pragma unroll
        for (int q = 0; q < 4; ++q) { w[q] = __builtin_amdgcn_cvt_pk_fp8_f32(s[(4 * q + 0) * 33], s[(4 * q + 1) * 33], 0, false); w[q] = __builtin_amdgcn_cvt_pk_fp8_f32(s[(4 * q + 2) * 33], s[(4 * q + 3) * 33], w[q], true); }
        *(u32x4*)(dst + (size_t)(drow0 + n) * K + k0 + 16 * c) = (u32x4){(unsigned)w[0], (unsigned)w[1], (unsigned)w[2], (unsigned)w[3]}; }
    LDS_WAIT(); asm volatile("" ::: "memory");
}
constexpr float QSCALE = SCALE * 1.4426950408889634f;
__device__ __forceinline__ void conv_plain_item(const float* W, int K, int N, bf16_t* dst, int item, int qmode, LAS float* scr, int lane) {
    const int nblk = N / 32, kb = item / nblk, nb = item % nblk, n0 = 32 * nb;
    const bool isq = qmode == 1 ? (n0 < 1024 || (n0 >= 3072 && n0 < 4096)) : (qmode == 2 ? n0 < 2048 : false);
    transpose_item(W, N, K, 64 * kb, n0, dst, n0, isq ? QSCALE : 1.0f, scr, lane);
}
__device__ __forceinline__ void conv_ffn_item(const Args& a, int l, int item, LAS float* scr, int lane) {
    const int m = item >> 11, r = item & 2047, kind = m >> 4, e = m & 15, kb = r >> 6, nb = r & 63, n0 = 32 * nb;
    const size_t eoff = ((size_t)l * NE + e) * (size_t)DM * EH;
    if (kind == 2) { transpose_item_f8(a.in[IN_WDOWN] + eoff, DM, EH, 64 * kb, n0, (unsigned char*)(a.ws + WS_WDN) + (size_t)e * DM * EH, n0, WDN_SCALE, scr, lane); }
    else { const float* W = (kind == 0 ? a.in[IN_WGATE] : a.in[IN_WUP]) + eoff;
           const int drow = (n0 >> 7) * 256 + (n0 & 127) + (kind == 1 ? 128 : 0);
           transpose_item_f8(W, EH, DM, 64 * kb, n0, (unsigned char*)(a.ws + WS_WGU) + (size_t)e * 4096 * DM, drow, WGU_SCALE, scr, lane); }
}

__device__ __forceinline__ void phase_prologue(const Args& a, LAS unsigned char* lds, int tid, int lane, int wave, int vcu, int G, int bx) {
    float* MOD = (float*)(a.ws + WS_MOD);
    for (int it = bx; it < 192; it += G) {
        const int l = it / 96, n0 = (it % 96) * 128;
        LAS float* cs = (LAS float*)lds;
        for (int i = tid; i < NB * DM; i += 512) { const int b = i >> 11, k = i & 2047; const float c = a.in[IN_C][i]; cs[k * 8 + b] = c / (1.f + expf(-c)); }
        __syncthreads();
        const int hl = lane >> 5, l32 = lane & 31;
        const float* W = a.in[IN_ADAW] + (size_t)l * DM * 6 * DM + n0 + 4 * l32;
        f32x4 acc[8];
#pragma unroll
        for (int b = 0; b < 8; ++b) acc[b] = (f32x4){0.f, 0.f, 0.f, 0.f};
        const int kbeg = wave * 256;
#pragma unroll 8
        for (int kk = 0; kk < 128; ++kk) { const int k = kbeg + 2 * kk + hl; const f32x4 w = *(const f32x4*)(W + (size_t)k * (6 * DM));
            const f32x4 c0 = *(const LAS f32x4*)(cs + k * 8), c1 = *(const LAS f32x4*)(cs + k * 8 + 4);
            acc[0] += w * c0[0]; acc[1] += w * c0[1]; acc[2] += w * c0[2]; acc[3] += w * c0[3]; acc[4] += w * c1[0]; acc[5] += w * c1[1]; acc[6] += w * c1[2]; acc[7] += w * c1[3]; }
        LAS float* part = (LAS float*)(lds + 65536);
#pragma unroll
        for (int b = 0; b < 8; ++b) { f32x4 s;
#pragma unroll
            for (int e = 0; e < 4; ++e) s[e] = swap32_add(acc[b][e], acc[b][e]);
            if (hl == 0) *(LAS f32x4*)(part + (wave * 8 + b) * 128 + 4 * l32) = s; }
        __syncthreads();
        for (int o = tid; o < 1024; o += 512) { const int b = o >> 7, col = o & 127; float s = 0.f;
#pragma unroll
            for (int w = 0; w < 8; ++w) s += part[(w * 8 + b) * 128 + col];
            MOD[(size_t)(l * 8 + b) * (6 * DM) + n0 + col] = s + a.in[IN_ADAB][l * 6 * DM + n0 + col]; }
        __syncthreads();
    }
    LAS float* scr = (LAS float*)(lds + wave * 16384);
    const int gw = vcu * 8 + wave, NGW = G * 8;
    constexpr int I_IN0 = (DM / 64) * (AB_IN / 32), I_OUT = (DM / 64) * (DM / 32), I_IN1 = (DM / 64) * (C_IN / 32), I_FFN = 48 * 2048;
    constexpr int NITEMS = I_IN0 + I_OUT + I_IN1 + I_OUT; (void)I_FFN;
    for (int it = gw; it < NITEMS; it += NGW) {
        int r = it;
        if (r < I_IN0) { const int n0 = 32 * (r % (AB_IN / 32));
            if (n0 < 3072) conv_plain_item(a.in[IN_ABWIN], DM, AB_IN, (bf16_t*)(a.ws + WS_WIN0), r, 1, scr, lane);
            else transpose_item_f8(a.in[IN_ABWIN], AB_IN, DM, 64 * (r / (AB_IN / 32)), n0, (unsigned char*)(a.ws + WS_WIN0) + (size_t)3072 * DM * 2, n0 - 3072, (n0 < 4096 ? QSCALE : 1.0f) * WIN1_SCALE, scr, lane);
            continue; } r -= I_IN0;
        if (r < I_OUT) { conv_plain_item(a.in[IN_ABWOUT], DM, DM, (bf16_t*)(a.ws + WS_WOUT0), r, 0, scr, lane); continue; } r -= I_OUT;
        if (r < I_IN1) { const int kb = r / (C_IN / 32), n0 = 32 * (r % (C_IN / 32)); transpose_item_f8(a.in[IN_CWIN], C_IN, DM, 64 * kb, n0, (unsigned char*)(a.ws + WS_WIN1), n0, (n0 < 2048 ? QSCALE : 1.0f) * WIN1_SCALE, scr, lane); continue; } r -= I_IN1;
        if (r < I_OUT) { const int kb = r / (DM / 32), nb = r % (DM / 32); transpose_item_f8(a.in[IN_CWOUT], DM, DM, 64 * kb, 32 * nb, (unsigned char*)(a.ws + WS_WOUT1), 32 * nb, WOUT_SCALE, scr, lane); continue; } r -= I_OUT;
    }
}

__device__ __forceinline__ void phase_modulate0(const Args& a, int lane, int wave, int vcu, int G) {
    const float* MOD = (const float*)(a.ws + WS_MOD); bf16_t* HB = (bf16_t*)(a.ws + WS_HB); unsigned char* H8 = (unsigned char*)(a.ws + WS_R2);
    const int gw = vcu * 8 + wave, NGW = G * 8;
#pragma unroll 1
    for (int row = gw; row < T; row += 2 * NGW) {
        f32x4 x[2][8];
#pragma unroll
        for (int p = 0; p < 2; ++p)
#pragma unroll
            for (int j = 0; j < 4; ++j)
#pragma unroll
                for (int q = 0; q < 2; ++q) x[p][2 * j + q] = *(const f32x4*)(a.in[IN_X] + (size_t)(row + p * NGW) * DM + 8 * lane + 512 * j + 4 * q);
#pragma unroll
        for (int p = 0; p < 2; ++p) { const int r = row + p * NGW; const float* mb = MOD + (size_t)(r >> 12) * (6 * DM);
#pragma unroll
            for (int j = 0; j < 4; ++j) { const int col = 8 * lane + 512 * j;
                const f32x4 s0 = *(const f32x4*)(mb + DM + col) + 1.0f, s1 = *(const f32x4*)(mb + DM + col + 4) + 1.0f, t0 = *(const f32x4*)(mb + col), t1 = *(const f32x4*)(mb + col + 4);
                const f32x4 h0 = x[p][2 * j] * s0 + t0, h1 = x[p][2 * j + 1] * s1 + t1;
                u32x4 w; w.x = cvtpk(h0[0], h0[1]); w.y = cvtpk(h0[2], h0[3]); w.z = cvtpk(h1[0], h1[1]); w.w = cvtpk(h1[2], h1[3]);
                *(u32x4*)(HB + (size_t)r * DM + col) = w;
                const f32x4 c0 = __builtin_elementwise_min(__builtin_elementwise_max(h0 * HIN1_SCALE, (f32x4){-448.f, -448.f, -448.f, -448.f}), (f32x4){448.f, 448.f, 448.f, 448.f}), c1 = __builtin_elementwise_min(__builtin_elementwise_max(h1 * HIN1_SCALE, (f32x4){-448.f, -448.f, -448.f, -448.f}), (f32x4){448.f, 448.f, 448.f, 448.f});
                unsigned w0, w1; asm volatile("v_cvt_pk_fp8_f32 %0, %1, %2" : "=v"(w0) : "v"(c0[0]), "v"(c0[1])); asm volatile("v_cvt_pk_fp8_f32 %0, %1, %2 op_sel:[0,0,1]" : "+v"(w0) : "v"(c0[2]), "v"(c0[3]));
                asm volatile("v_cvt_pk_fp8_f32 %0, %1, %2" : "=v"(w1) : "v"(c1[0]), "v"(c1[1])); asm volatile("v_cvt_pk_fp8_f32 %0, %1, %2 op_sel:[0,0,1]" : "+v"(w1) : "v"(c1[2]), "v"(c1[3]));
                *(u32x2*)(H8 + (size_t)r * DM + col) = (u32x2){w0, w1}; } }
    }
}

__device__ __forceinline__ void norms_item(const Args& a, int it, const int wave0) {
    const bf16_t* P = (const bf16_t*)(a.ws + WS_R1); unsigned* NRM = (unsigned*)(a.ws + WS_CTL) + CW_NRM;
    const int lane = ({ int l_; asm volatile("v_mbcnt_lo_u32_b32 %0, -1, 0\n\tv_mbcnt_hi_u32_b32 %0, -1, %0" : "=v"(l_)); l_; });
    const int wid = wave0, r32 = lane & 31, hi = lane >> 5;
    {
        const int kind = it & 1, rest = it >> 1, combo = rest >> 4, qb = rest & 15, b = combo >> 3, h = (combo >> 1) & 3, map = combo & 1;
        const bf16_t* base = P + (size_t)(b * SEQ + qb * 256 + wid * 32 + r32) * AB_IN + (kind ? 1024 : 0) + (h * 2 + map) * 128 + hi * 8;
        float ss = 0.f, dot = 0.f;
#pragma unroll
        for (int d0 = 0; d0 < 8; ++d0) { const u32x4 v = *(const u32x4*)(base + d0 * 16);
            ss += bf_lo(v.x) * bf_lo(v.x) + bf_hi(v.x) * bf_hi(v.x) + bf_lo(v.y) * bf_lo(v.y) + bf_hi(v.y) * bf_hi(v.y) + bf_lo(v.z) * bf_lo(v.z) + bf_hi(v.z) * bf_hi(v.z) + bf_lo(v.w) * bf_lo(v.w) + bf_hi(v.w) * bf_hi(v.w);
            if (kind == 0) { const u32x4 w = *(const u32x4*)(base + 1024 + d0 * 16);
                dot += bf_lo(v.x) * bf_lo(w.x) + bf_hi(v.x) * bf_hi(w.x) + bf_lo(v.y) * bf_lo(w.y) + bf_hi(v.y) * bf_hi(w.y) + bf_lo(v.z) * bf_lo(w.z) + bf_hi(v.z) * bf_hi(w.z) + bf_lo(v.w) * bf_lo(w.w) + bf_hi(v.w) * bf_hi(w.w); } }
        ss += shx(ss, 32, lane); dot += shx(dot, 32, lane);
        float nd = fmaxf(-dot, 0.f);
#pragma unroll
        for (int o = 1; o < 32; o <<= 1) { ss = fmaxf(ss, shx(ss, o, lane)); nd = fmaxf(nd, shx(nd, o, lane)); }
        if (lane == 0) { __hip_atomic_fetch_max(NRM + (kind ? 1024 + combo : combo * 16 + qb), __float_as_uint(ss * 1.0001f), __ATOMIC_RELAXED, __HIP_MEMORY_SCOPE_AGENT);
            if (kind == 0) __hip_atomic_fetch_max(NRM + 1088 + combo * 16 + qb, __float_as_uint(nd * 1.0001f + 0.01f), __ATOMIC_RELAXED, __HIP_MEMORY_SCOPE_AGENT); }
    }
}

__device__ __forceinline__ float slope_pow2_half(int k) { return __builtin_amdgcn_exp2f(-(float)(k >> 1)) * ((k & 1) ? 0.70710678118654752f : 1.0f); }
__device__ __forceinline__ void phase_attention(const Args& a, int l, LAS unsigned char* lds, int G, int bx, const int wave0, const int part  ) {
    LAS char* L = (LAS char*)lds;
    const int nband = (l == 0) ? 3072 : 2048;
    int cv_n = (part == 2) ? 2 * ((nband - bx + G - 1) / G) : 0;
#define CV_ITEMS(K) do { { const int cvl_ = ({ int l_; asm volatile("v_mbcnt_lo_u32_b32 %0, -1, 0\n\tv_mbcnt_hi_u32_b32 %0, -1, %0" : "=v"(l_)); l_; }); LAS float* cvs_ = (LAS float*)(lds + wave0 * 8448); \
        for (int q_ = 0; q_ < (K); ++q_) { const int it_ = (bx + cv_n * G) * 8 + wave0; if (it_ >= 48 * 2048) break; conv_ffn_item(a, l, it_, cvs_, cvl_); ++cv_n; } } } while (0)
    if (part & 1) {
    for (int repB_ = 0; repB_ < PH_REP(13); ++repB_)
    for (int i = 0; ; ++i) { const int u = i * G + bx; if (u >= nband) break;
        const bf16_t *Qb, *Kt, *Vt; bf16_t* Ob; float* Lb; int ldq, ldo, ldl; int q0, n, rad; float slope, sinkR;
        if (l == 0) {
            const bf16_t* P = (const bf16_t*)(a.ws + WS_R1);
            const int br = u >> 10, rem = u & 1023, b = rem >> 7, h = (rem >> 4) & 7, j = rem & 15;
            const int d = br == 0 ? 1 : (br == 1 ? 4 : 16), res = j & (d - 1), qb = br == 0 ? j : (br == 1 ? (j >> 2) : 0);
            n = SEQ / d; q0 = qb * 256; rad = 64; ldq = d * AB_IN; ldo = d * 512; ldl = d * 8;
            const size_t tok0 = (size_t)b * SEQ + res;
            Qb = P + tok0 * AB_IN + 3072 + h * 128; Kt = P + tok0 * AB_IN + 4096 + h * 128; Vt = P + tok0 * AB_IN + 5120 + h * 128;
            Ob = (bf16_t*)((unsigned char*)(a.ws + WS_R2) + (size_t)br * T * 1024 + tok0 * 1024 + h * 128);
            Lb = (float*)(a.ws + WS_LSE) + (size_t)br * T * 8 + tok0 * 8 + h;
            slope = __builtin_amdgcn_exp2f(-(float)(h + 1)) * (float)d; sinkR = -INFINITY;
        } else {
            const bf16_t* P = (const bf16_t*)(a.ws + WS_R1);
            const int combo = (u >> 9) * 8 + (u & 7), sub = (u & 511) >> 3, b = combo >> 2, kvh = combo & 3, g = sub >> 4, qb = sub & 15, hq = kvh * 4 + g;
            n = SEQ; q0 = qb * 256; rad = 128; ldq = C_IN; ldo = DM / 2; ldl = 0;
            const size_t tok0 = (size_t)b * SEQ;
            Qb = P + tok0 * C_IN + hq * 128; Kt = P + tok0 * C_IN + 2048 + kvh * 128; Vt = P + tok0 * C_IN + 2560 + kvh * 128;
            Ob = (bf16_t*)((unsigned char*)(a.ws + WS_HB) + tok0 * DM + hq * 128); Lb = nullptr;
            slope = slope_pow2_half(hq + 1); { float l2e_ = 1.4426950408889634f; asm volatile("" : "+s"(l2e_)); sinkR = a.in[IN_CSINK][hq] * l2e_; }
        }
        const int nt_tot = n / 64, nblk = rad / 64;
        int t_lo = q0 / 64 - nblk; if (t_lo < 0) t_lo = 0;
        int t_hi = q0 / 64 + 4 + nblk; if (t_hi > nt_tot) t_hi = nt_tot;
        if ((t_hi - t_lo) & 1) { if (t_hi < nt_tot) ++t_hi; else --t_lo; }
        att::attn_unit<true>(Qb + (long)(q0 * ldq), ldq, Kt + (long)(t_lo * 64 * ldq), Vt + (long)(t_lo * 64 * ldq), ldq, Ob + (long)(q0 * ldo), ldo,
                             Lb ? Lb + (long)(q0 * ldl) : nullptr, ldl, q0 - t_lo * 64, t_hi - t_lo, -slope * 1.4426950408889634f, (float)rad, sinkR, L, wave0, true);
        cv_n = (l == 0 ? 2 : 6) * i; CV_ITEMS(l == 0 ? 2 : 6);
        if (l == 0 && bx + i * G < 2048) norms_item(a, bx + i * G, wave0);
    }
    if (l == 0) for (int n_ = (nband - bx + G - 1) / G; bx + n_ * G < 2048; ++n_) norms_item(a, bx + n_ * G, wave0);
    cv_n = (l == 0 ? 2 : 6) * ((nband - bx + G - 1) / G);
    }
    for (int repA_ = 0; repA_ < PH_REP(12); ++repA_)
    if (l == 0 && (part & 2)) {
        const bf16_t* P = (const bf16_t*)(a.ws + WS_R1); bf16_t* OA = (bf16_t*)(a.ws + WS_R3);
        const unsigned* NRM = (const unsigned*)(a.ws + WS_CTL) + CW_NRM;
        for (int i = 0; ; ++i) { const int u = i * G + bx; if (u >= 1024) break;
            const int rnd = u >> 8, x = u & 7, sub = (u & 255) >> 3, b = 2 * rnd + (sub >> 4), h = ((x >> 1) + rnd) & 3, map = x & 1, qb = (rnd & 2) ? 15 - (sub & 15) : (sub & 15), combo = (b * 4 + h) * 2 + map;
            const float slope = __builtin_amdgcn_exp2f(-2.0f * (float)(h + 1));
            const float smax2 = sqrtf(__uint_as_float(NRM[combo * 16 + qb]) * __uint_as_float(NRM[1024 + combo]));
            const float sl2 = slope * 1.4426950408889634f;
            const float mlb2 = -__uint_as_float(NRM[1088 + combo * 16 + qb]);
            const float dmf = fminf((smax2 - mlb2 + 43.3f) / sl2 + 1.0f, 65536.0f); const int dmax = (int)dmf, q0 = qb * 256;
            int lo = q0 - dmax; if (lo < 0) lo = 0; const int t_lo = lo >> 6; int t_hi = ((q0 + 255 + dmax) >> 6) + 1; if (t_hi > SEQ / 64) t_hi = SEQ / 64;
            const bf16_t* Qb = P + (size_t)(b * SEQ + q0) * AB_IN + (h * 2 + map) * 128;
            const bf16_t* Kt = P + (size_t)(b * SEQ + t_lo * 64) * AB_IN + 1024 + (h * 2 + map) * 128;
            const bf16_t* Vt = P + (size_t)(b * SEQ + t_lo * 64) * AB_IN + 2048 + h * 256;
            bf16_t* Ob = OA + (size_t)(b * SEQ + q0) * DM + (h * 2 + map) * 256;
            att::attn_unit256(Qb, AB_IN, Kt, Vt, AB_IN, Ob, DM, q0 - t_lo * 64, t_hi - t_lo, -sl2, L, wave0);
            CV_ITEMS(6);
        }
    }
    if (part & 2) CV_ITEMS(48 * 2048);
}

#undef CV_ITEMS
__device__ __forceinline__ void phase_combine(const Args& a, int l, int lane, int wave, int vcu, int G) {
    bf16_t* Y = (bf16_t*)(a.ws + WS_HB);
    const int gw = vcu * 8 + wave, NGW = G * 8;
    if (l == 0) {
        const float* dl = a.in[IN_DLAM];
        const float d01 = wave_sum(dl[lane] * dl[128 + lane] + dl[64 + lane] * dl[192 + lane], lane);
        const float d23 = wave_sum(dl[256 + lane] * dl[384 + lane] + dl[320 + lane] * dl[448 + lane], lane);
        const float lam = expf(d01) - expf(d23) + LAM_INIT0;
        const f32x4 g4 = *(const f32x4*)(a.in[IN_SUBLN] + 4 * lane) * (1.0f - LAM_INIT0);
        const bf16_t* OA = (const bf16_t*)(a.ws + WS_R3); const unsigned char* OB = (const unsigned char*)(a.ws + WS_R2); const float* LSE = (const float*)(a.ws + WS_LSE);
        u32x2 an[8]; u32x4 bn[3]; float ln_[3];
#define CMB_LOAD(row_) do { const bf16_t* oa_ = OA + (size_t)(row_) * DM; const int hb_ = lane >> 3; \
            _Pragma("unroll") for (int h = 0; h < 4; ++h) { an[2 * h] = *(const u32x2*)(oa_ + h * 512 + 4 * lane); an[2 * h + 1] = *(const u32x2*)(oa_ + h * 512 + 256 + 4 * lane); } \
            { const size_t off_ = (size_t)(row_) * 1024 + 16 * lane; bn[0] = *(const u32x4*)(OB + off_); bn[1] = *(const u32x4*)(OB + (size_t)T * 1024 + off_); bn[2] = *(const u32x4*)(OB + (size_t)2 * T * 1024 + off_); } \
            ln_[0] = LSE[(size_t)(row_) * 8 + hb_]; ln_[1] = LSE[(size_t)T * 8 + (size_t)(row_) * 8 + hb_]; ln_[2] = LSE[(size_t)2 * T * 8 + (size_t)(row_) * 8 + hb_]; } while (0)
        asm volatile("" :: "v"(g4), "v"(lam));
        if (gw < T) CMB_LOAD(gw);
#pragma unroll 1
        for (int row = gw; row < T; row += NGW) {
            bf16_t* y = Y + (size_t)row * DM;
            u32x2 ac[8]; u32x4 bc[3];
#pragma unroll
            for (int k = 0; k < 8; ++k) ac[k] = an[k];
#pragma unroll
            for (int k = 0; k < 3; ++k) bc[k] = bn[k];
            const float l0 = ln_[0], l1 = ln_[1], l2 = ln_[2];
            if (row + NGW < T) CMB_LOAD(row + NGW);
#pragma unroll
            for (int h = 0; h < 4; ++h) { const u32x2 a0 = ac[2 * h], a1 = ac[2 * h + 1];
                const f32x4 o0 = {bf_lo(a0.x), bf_hi(a0.x), bf_lo(a0.y), bf_hi(a0.y)}, o1 = {bf_lo(a1.x), bf_hi(a1.x), bf_lo(a1.y), bf_hi(a1.y)};
                const f32x4 dd = o0 - o1 * lam; const float ss = wave_sum_v(dd[0] * dd[0] + dd[1] * dd[1] + dd[2] * dd[2] + dd[3] * dd[3]);
                const float rs = 1.0f / sqrtf(ss * (1.0f / 256.0f) + LN_EPS); const f32x4 r = dd * rs * g4;
                u32x2 w; w.x = cvtpk(r[0], r[1]); w.y = cvtpk(r[2], r[3]); *(u32x2*)(y + h * 256 + 4 * lane) = w; }
            const float mx = fmaxf(l0, fmaxf(l1, l2)); const float e0 = expf(l0 - mx), e1 = expf(l1 - mx), e2 = expf(l2 - mx); const float inv = 1.0f / (e0 + e1 + e2);
            const float w0 = e0 * inv * (1.0f / YATT_SCALE), w1 = e1 * inv * (1.0f / YATT_SCALE), w2 = e2 * inv * (1.0f / YATT_SCALE);
            u32x4 wv[2];
#pragma unroll
            for (int d = 0; d < 4; ++d) {
                const f32x2 x0 = __builtin_amdgcn_cvt_pk_f32_fp8((int)bc[0][d], false), x1 = __builtin_amdgcn_cvt_pk_f32_fp8((int)bc[0][d], true);
                const f32x2 y0 = __builtin_amdgcn_cvt_pk_f32_fp8((int)bc[1][d], false), y1 = __builtin_amdgcn_cvt_pk_f32_fp8((int)bc[1][d], true);
                const f32x2 z0 = __builtin_amdgcn_cvt_pk_f32_fp8((int)bc[2][d], false), z1 = __builtin_amdgcn_cvt_pk_f32_fp8((int)bc[2][d], true);
                const f32x2 s0 = x0 * w0 + y0 * w1 + z0 * w2, s1 = x1 * w0 + y1 * w1 + z1 * w2;
                wv[d >> 1][(d & 1) * 2] = cvtpk(s0.x, s0.y); wv[d >> 1][(d & 1) * 2 + 1] = cvtpk(s1.x, s1.y); }
            *(u32x4*)(y + 1024 + 16 * lane) = wv[0]; *(u32x4*)(y + 1024 + 16 * lane + 8) = wv[1];
        }
#undef CMB_LOAD
    }
}

#define LDS_BARRIER() asm volatile("s_waitcnt lgkmcnt(0)\n\ts_barrier" ::: "memory")
constexpr int RP = 1;
__device__ __forceinline__ void phase_ln1_router(const Args& a, int l, const float* __restrict__ X, LAS unsigned char* lds, int tid, int lane, int wave, int vcu, int G) {
    const bool xh = l != 0; const unsigned short* Xh = (const unsigned short*)(a.ws + WS_X1) + (size_t)T * DM;
    const float* MOD = (const float*)(a.ws + WS_MOD); const bf16_t* YO = (const bf16_t*)(a.ws + WS_R3);
    unsigned short* X1 = (unsigned short*)(a.ws + WS_X1); unsigned char* HB = (unsigned char*)(a.ws + WS_HB); float* AFF = (float*)(a.ws + WS_AFF);
    LAS f32x4* WL = (LAS f32x4*)lds;
    LAS f32x2* stat = (LAS f32x2*)(lds + 132096);
    LAS float* plog = (LAS float*)(lds + 132096 + 256);
    const int pr = wave >> 1, hf = wave & 1;
    { const float* Wr = a.in[IN_ROUTER] + (size_t)l * DM * NE;
      for (int i = tid; i < DM * 4; i += 512) { const int col = i >> 2, q = i & 3; const f32x4 w = *(const f32x4*)(Wr + (size_t)col * NE + 4 * q);
          WL[((((col >> 10) * 4 + ((col >> 8) & 3)) * 4 + (col & 3)) * 4 + q) * 64 + ((col & 255) >> 2)] = w; } }
    f32x4 lng[4], lnb[4];
#pragma unroll
    for (int j = 0; j < 4; ++j) { const int c = 1024 * hf + 256 * j + 4 * lane; lng[j] = *(const f32x4*)(a.in[IN_LNG] + (size_t)(l * 2 + 0) * DM + c); lnb[j] = *(const f32x4*)(a.in[IN_LNB] + (size_t)(l * 2 + 0) * DM + c); }
    asm volatile("" :: "v"(lng[0]), "v"(lng[1]), "v"(lng[2]), "v"(lng[3]), "v"(lnb[0]), "v"(lnb[1]), "v"(lnb[2]), "v"(lnb[3]));
    __syncthreads();
    const LAS f32x4* wl = WL + hf * (16 * 4 * 64) + lane;
    for (int blk = vcu; blk < T / 128; blk += G) {
        const int b = blk >> 5; const float* mb = MOD + (size_t)(l * 8 + b) * (6 * DM);
        f32x4 g1[4], sh2[4], sc2[4];
#pragma unroll
        for (int j = 0; j < 4; ++j) { const int c = 1024 * hf + 256 * j + 4 * lane; g1[j] = *(const f32x4*)(mb + 2 * DM + c); sh2[j] = *(const f32x4*)(mb + 3 * DM + c); sc2[j] = *(const f32x4*)(mb + 4 * DM + c) + 1.0f; }
        asm volatile("" :: "v"(g1[0]), "v"(g1[1]), "v"(g1[2]), "v"(g1[3]), "v"(sh2[0]), "v"(sh2[1]), "v"(sh2[2]), "v"(sh2[3]), "v"(sc2[0]), "v"(sc2[1]), "v"(sc2[2]), "v"(sc2[3]));
        f32x4 xr[RP][4]; u32x2 yr[RP][4];
#pragma unroll
        for (int i = 0; i < RP; ++i)
#pragma unroll
            for (int j = 0; j < 4; ++j) { const size_t off = (size_t)(blk * 128 + pr * RP + i) * DM + 1024 * hf + 256 * j + 4 * lane; if (xh) { const u32x2 t_ = *(const u32x2*)(Xh + off); xr[i][j] = (f32x4){__uint_as_float(t_.x), __uint_as_float(t_.y), 0.f, 0.f}; } else xr[i][j] = *(const f32x4*)(X + off); if (xh) yr[i][j] = (u32x2){*(const unsigned*)((const unsigned char*)YO + off), 0u}; else yr[i][j] = *(const u32x2*)(YO + off); }
#pragma unroll 1
        for (int bt = 0; bt < 32 / RP; ++bt) {
            const int row0 = blk * 128 + bt * (4 * RP) + pr * RP;
            f32x4 v[RP][4];
#pragma unroll
            for (int i = 0; i < RP; ++i)
#pragma unroll
                for (int j = 0; j < 4; ++j) { f32x4 y = {bf_lo(yr[i][j].x), bf_hi(yr[i][j].x), bf_lo(yr[i][j].y), bf_hi(yr[i][j].y)};
                    if (xh) { const f32x2 ya_ = __builtin_amdgcn_cvt_pk_f32_fp8((int)yr[i][j].x, false), yb_ = __builtin_amdgcn_cvt_pk_f32_fp8((int)yr[i][j].x, true); y = (f32x4){ya_.x, ya_.y, yb_.x, yb_.y} * (1.0f / YO1_SCALE); }
                    f32x4 xv = xr[i][j]; if (xh) { const unsigned a_ = __float_as_uint(xv[0]), b_ = __float_as_uint(xv[1]); xv = (f32x4){h_lo(a_), h_hi(a_), h_lo(b_), h_hi(b_)}; }
                    v[i][j] = xv * ALPHA + g1[j] * y; }
            if (bt + 1 < 32 / RP) {
#pragma unroll
                for (int i = 0; i < RP; ++i)
#pragma unroll
                    for (int j = 0; j < 4; ++j) { const size_t off = (size_t)(row0 + 4 * RP + i) * DM + 1024 * hf + 256 * j + 4 * lane; if (xh) { const u32x2 t_ = *(const u32x2*)(Xh + off); xr[i][j] = (f32x4){__uint_as_float(t_.x), __uint_as_float(t_.y), 0.f, 0.f}; } else xr[i][j] = *(const f32x4*)(X + off); if (xh) yr[i][j] = (u32x2){*(const unsigned*)((const unsigned char*)YO + off), 0u}; else yr[i][j] = *(const u32x2*)(YO + off); } }
#pragma unroll
            for (int i = 0; i < RP; ++i) { const f32x4 s4 = (v[i][0] + v[i][1]) + (v[i][2] + v[i][3]); const float mw = wave_sum_v((s4[0] + s4[1]) + (s4[2] + s4[3])) * (1.0f / 1024.0f);
                f32x4 q4 = {0.f, 0.f, 0.f, 0.f};
#pragma unroll
                for (int j = 0; j < 4; ++j) { const f32x4 d = v[i][j] - mw; q4 += d * d; }
                const float q = wave_sum_v((q4[0] + q4[1]) + (q4[2] + q4[3]));
                if (lane == 0) stat[(pr * RP + i) * 2 + hf] = (f32x2){mw, q}; }
            LDS_BARRIER();
            f32x4 p[RP][4];
#pragma unroll
            for (int i = 0; i < RP; ++i) {
                const f32x2 s0 = stat[(pr * RP + i) * 2], s1 = stat[(pr * RP + i) * 2 + 1];
                const float mean = (s0[0] + s1[0]) * 0.5f, d0 = s0[0] - mean, d1 = s1[0] - mean, m2 = (s0[1] + s1[1]) + 1024.0f * (d0 * d0 + d1 * d1);
                const float rstd = 1.0f / sqrtf(m2 * (1.0f / 2048.0f) + LN_EPS);
#pragma unroll
                for (int j = 0; j < 4; ++j) { const f32x4 x1 = (v[i][j] - mean) * rstd * lng[j] + lnb[j]; const f32x4 h2 = x1 * sc2[j] + sh2[j];
                    const size_t off = (size_t)(row0 + i) * DM + 1024 * hf + 256 * j + 4 * lane;
                    *(u32x2*)(X1 + off) = (u32x2){pkh(x1[0], x1[1]), pkh(x1[2], x1[3])};
                    const f32x4 hs = __builtin_elementwise_min(__builtin_elementwise_max(h2 * H2_SCALE, (f32x4){-448.f, -448.f, -448.f, -448.f}), (f32x4){448.f, 448.f, 448.f, 448.f});
                    int hw = __builtin_amdgcn_cvt_pk_fp8_f32(hs[0], hs[1], 0, false); hw = __builtin_amdgcn_cvt_pk_fp8_f32(hs[2], hs[3], hw, true);
                    *(int*)(HB + off) = hw;
                    v[i][j] = h2; }
#pragma unroll
                for (int q = 0; q < 4; ++q) p[i][q] = (f32x4){0.f, 0.f, 0.f, 0.f};
            }
#pragma unroll
            for (int j = 0; j < 4; ++j)
#pragma unroll
                for (int t = 0; t < 4; ++t) {
                    f32x4 w[4];
#pragma unroll
                    for (int q = 0; q < 4; ++q) w[q] = wl[((j * 4 + t) * 4 + q) * 64];
#pragma unroll
                    for (int i = 0; i < RP; ++i)
#pragma unroll
                        for (int q = 0; q < 4; ++q) p[i][q] += w[q] * v[i][j][t];
                    if (t & 1) asm volatile("" ::: "memory"); }
#pragma unroll
            for (int i = 0; i < RP; ++i) { float t8[8], t4[4], t2[2];
#pragma unroll
                for (int k = 0; k < 8; ++k) t8[k] = swap32_add(p[i][k >> 2][k & 3], p[i][2 + (k >> 2)][k & 3]);
#pragma unroll
                for (int k = 0; k < 4; ++k) t4[k] = swap16_add(t8[k], t8[4 + k]);
                const bool up3 = (lane & 8) != 0;
#pragma unroll
                for (int k = 0; k < 2; ++k) { const float mine = up3 ? t4[2 + k] : t4[k], theirs = up3 ? t4[k] : t4[2 + k]; t2[k] = sum8_dpp(mine + dpp_mov<0x128>(theirs)); }
                if ((lane & 7) == 0) *(LAS f32x2*)(plog + ((pr * RP + i) * 2 + hf) * 16 + (lane >> 3) * 2) = (f32x2){t2[0], t2[1]}; }
            LDS_BARRIER();
            if (lane < 16 && wave < 4 * RP) { const int r8 = wave; const float lg = plog[(r8 * 2) * 16 + lane] + plog[(r8 * 2 + 1) * 16 + lane];
                float mx = lg;
#pragma unroll
                for (int o = 1; o < 16; o <<= 1) mx = fmaxf(mx, shx(mx, o, lane));
                const float ex = expf(lg - mx); float sm = ex;
#pragma unroll
                for (int o = 1; o < 16; o <<= 1) sm += shx(sm, o, lane);
                const int row = blk * 128 + bt * (4 * RP) + r8; AFF[((size_t)(b * NE + lane)) * SEQ + (row & (SEQ - 1))] = ex / sm; }
        }
        LDS_BARRIER();
    }
    __syncthreads();
}

__device__ __forceinline__ int block_excl_scan(int v, LAS int* wsum, int lane, int wave, int& total) {
    int x = v;
#pragma unroll
    for (int o = 1; o < 64; o <<= 1) { const int y = shup_i(x, o, lane); if (lane >= o) x += y; }
    if (lane == 63) wsum[wave] = x;
    __syncthreads();
    int off = 0, tot = 0;
#pragma unroll
    for (int w = 0; w < 8; ++w) { const int s = wsum[w]; off += (w < wave) ? s : 0; tot += s; }
    __syncthreads();
    total = tot; return off + x - v;
}
__device__ __forceinline__ void phase_topk(const Args& a, LAS unsigned char* lds, int tid, int lane, int wave, int G, int bx) {
    const float* AFF = (const float*)(a.ws + WS_AFF); int* IDX = (int*)(a.ws + WS_IDX); int* INVC = (int*)(a.ws + WS_INVC); float* INVG = (float*)(a.ws + WS_INVG);
    LAS unsigned* hist = (LAS unsigned*)lds;
    LAS int* wsum = (LAS int*)(lds + 1024);
    LAS int* selw = (LAS int*)(lds + 1024 + 64);
    for (int it = bx; it < NB * NE; it += G) {
        const int b = it >> 4, e = it & 15;
        const float* av = AFF + (size_t)it * SEQ + 8 * tid;
        const f32x4 v0 = *(const f32x4*)av, v1 = *(const f32x4*)(av + 4);
        unsigned u[8] = {__float_as_uint(v0[0]), __float_as_uint(v0[1]), __float_as_uint(v0[2]), __float_as_uint(v0[3]), __float_as_uint(v1[0]), __float_as_uint(v1[1]), __float_as_uint(v1[2]), __float_as_uint(v1[3])};
        unsigned prefix = 0u; int kk = CAP;
#pragma unroll
        for (int pass = 0; pass < 4; ++pass) {
            const int shift = 24 - 8 * pass; const unsigned mhi = pass == 0 ? 0u : (0xFFFFFFFFu << (shift + 8));
            if (tid < 256) hist[tid] = 0u;
            __syncthreads();
#pragma unroll
            for (int i = 0; i < 8; ++i) if ((u[i] & mhi) == prefix) __hip_atomic_fetch_add(&hist[(u[i] >> shift) & 255u], 1u, __ATOMIC_RELAXED, __HIP_MEMORY_SCOPE_WORKGROUP);
            __syncthreads();
            const int bin = 255 - tid; const int h = tid < 256 ? (int)hist[bin] : 0; int tot;
            const int excl = block_excl_scan(h, wsum, lane, wave, tot);
            if (tid < 256 && excl < kk && kk <= excl + h) { selw[0] = bin; selw[1] = excl; }
            __syncthreads();
            prefix |= (unsigned)selw[0] << shift; kk -= selw[1];
            __syncthreads();
        }
        int ngt = 0, neq = 0;
#pragma unroll
        for (int i = 0; i < 8; ++i) { ngt += u[i] > prefix ? 1 : 0; neq += u[i] == prefix ? 1 : 0; }
        int tgt, teq;
        int pg = block_excl_scan(ngt, wsum, lane, wave, tgt);
        int pe = block_excl_scan(neq, wsum, lane, wave, teq);
#pragma unroll
        for (int i = 0; i < 8; ++i) { const int s = 8 * tid + i; int c = -1;
            if (u[i] > prefix) c = pg++;
            else if (u[i] == prefix) { if (pe < kk) c = tgt + pe; ++pe; }
            const size_t tok = (size_t)b * SEQ + s;
            INVC[tok * NE + e] = c; INVG[tok * NE + e] = __uint_as_float(u[i]);
            if (c >= 0) IDX[(size_t)it * CAP + c] = (int)(((unsigned)b * SEQ + (unsigned)s) * (unsigned)DM); }
        __syncthreads();
    }
}

__device__ __forceinline__ void phase_gather(const Args& a, int lane, int wave, int vcu, int G) {
    const int* IDX = (const int*)(a.ws + WS_IDX); const bf16_t* HB = (const bf16_t*)(a.ws + WS_HB); bf16_t* XG = (bf16_t*)(a.ws + WS_R1);
    for (int slot = vcu * 8 + wave; slot < NSLOT; slot += G * 8) {
        const int b = slot >> 13, tok = IDX[slot]; const unsigned char* src = (const unsigned char*)HB + ((size_t)b * SEQ + tok) * DM; unsigned char* dst = (unsigned char*)XG + (size_t)slot * DM;
        u32x4 t[2];
#pragma unroll
        for (int j = 0; j < 2; ++j) t[j] = *(const u32x4*)(src + 16 * lane + 1024 * j);
#pragma unroll
        for (int j = 0; j < 2; ++j) *(u32x4*)(dst + 16 * lane + 1024 * j) = t[j];
    }
}

__device__ __forceinline__ void phase_ffn_combine(const Args& a, int l, float* __restrict__ OUT, LAS unsigned char* lds, int tid, int lane, int wave, int vcu, int G) {
    const float* MOD = (const float*)(a.ws + WS_MOD); const unsigned short* X1 = (const unsigned short*)(a.ws + WS_X1); const unsigned char* YD8 = (const unsigned char*)(a.ws + WS_R3);
    const int* INVC = (const int*)(a.ws + WS_INVC); const float* INVG = (const float*)(a.ws + WS_INVG); bf16_t* HB = (bf16_t*)(a.ws + WS_HB);
    LAS float* vg2 = (LAS float*)lds; LAS float* vlg = vg2 + DM; LAS float* vlb = vlg + DM; LAS float* vsc = vlb + DM; LAS float* vsh = vsc + DM;
    for (int blk = vcu; blk < T / 128; blk += G) {
        const int b = blk >> 5; const float* mb = MOD + (size_t)(l * 8 + b) * (6 * DM); const float* mbn = MOD + (size_t)(8 + b) * (6 * DM);
        __syncthreads();
        for (int i = tid; i < DM; i += 512) { vg2[i] = mb[5 * DM + i]; vlg[i] = a.in[IN_LNG][(size_t)(l * 2 + 1) * DM + i]; vlb[i] = a.in[IN_LNB][(size_t)(l * 2 + 1) * DM + i];
            vsc[i] = mbn[DM + i] + 1.0f; vsh[i] = mbn[i]; }
        __syncthreads();
        int ic_n = lane < 16 ? INVC[(size_t)(blk * 128 + wave * 16) * NE + lane] : -1; float ig_n = lane < 16 ? INVG[(size_t)(blk * 128 + wave * 16) * NE + lane] : 0.f;
        u32x4 xn_[4];
#pragma unroll
        for (int j = 0; j < 2; ++j)
#pragma unroll
            for (int q = 0; q < 2; ++q) xn_[2 * j + q] = *(const u32x4*)(X1 + (size_t)(blk * 128 + wave * 16) * DM + 16 * lane + 1024 * j + 8 * q);
#pragma unroll 1
        for (int r = 0; r < 16; ++r) {
            const int row = blk * 128 + wave * 16 + r;
            const int ic = ic_n; const float ig = ig_n; u32x4 xc[4];
#pragma unroll
            for (int j = 0; j < 4; ++j) xc[j] = xn_[j];
            if (r + 1 < 16) { ic_n = lane < 16 ? INVC[(size_t)(row + 1) * NE + lane] : -1; ig_n = lane < 16 ? INVG[(size_t)(row + 1) * NE + lane] : 0.f;
#pragma unroll
                for (int j = 0; j < 2; ++j)
#pragma unroll
                    for (int q = 0; q < 2; ++q) xn_[2 * j + q] = *(const u32x4*)(X1 + (size_t)(row + 1) * DM + 16 * lane + 1024 * j + 8 * q); }
            float y[32];
#pragma unroll
            for (int k = 0; k < 32; ++k) y[k] = 0.f;
            unsigned mask = (unsigned)__builtin_amdgcn_ballot_w64(ic >= 0) & 0xFFFFu;
            while (mask) {
                int ek[3]; float gk[3]; const unsigned char* yr[3];
#pragma unroll
                for (int k = 0; k < 3; ++k) { const bool ok = mask != 0u; const int e = ok ? __builtin_ctz(mask) : 0; if (ok) mask &= mask - 1u; ek[k] = e;
                    const int c = __builtin_amdgcn_readlane(ic, e); gk[k] = ok ? __uint_as_float((unsigned)__builtin_amdgcn_readlane((int)__float_as_uint(ig), e)) * (1.0f / YD_SCALE) : 0.f;
                    yr[k] = YD8 + ((size_t)(b * NE + e) * CAP + (ok ? c : 0)) * DM + 16 * lane; }
                u32x4 w[3][2];
#pragma unroll
                for (int k = 0; k < 3; ++k)
#pragma unroll
                    for (int j = 0; j < 2; ++j) w[k][j] = *(const u32x4*)(yr[k] + 1024 * j);
#pragma unroll
                for (int k = 0; k < 3; ++k)
#pragma unroll
                    for (int j = 0; j < 2; ++j) { const float gs = gk[k];
#pragma unroll
                        for (int d = 0; d < 4; ++d) { const f32x2 lo = __builtin_amdgcn_cvt_pk_f32_fp8((int)w[k][j][d], false), hi = __builtin_amdgcn_cvt_pk_f32_fp8((int)w[k][j][d], true);
                            y[16 * j + 4 * d + 0] += gs * lo[0]; y[16 * j + 4 * d + 1] += gs * lo[1]; y[16 * j + 4 * d + 2] += gs * hi[0]; y[16 * j + 4 * d + 3] += gs * hi[1]; } }
            }
            float v[32]; float s = 0.f;
#pragma unroll
            for (int j = 0; j < 2; ++j)
#pragma unroll
                for (int q = 0; q < 4; ++q) { const int col = 16 * lane + 1024 * j + 4 * q; const unsigned xw0 = xc[2 * j + (q >> 1)][(q & 1) * 2], xw1 = xc[2 * j + (q >> 1)][(q & 1) * 2 + 1]; const f32x4 xa = {h_lo(xw0), h_hi(xw0), h_lo(xw1), h_hi(xw1)}; const f32x4 ga = *(const LAS f32x4*)(vg2 + col);
#pragma unroll
                    for (int t = 0; t < 4; ++t) v[16 * j + 4 * q + t] = xa[t] * ALPHA + ga[t] * y[16 * j + 4 * q + t]; }
#pragma unroll
            for (int k = 0; k < 32; ++k) s += v[k];
            const float mean = wave_sum(s, lane) * (1.0f / DM); float q2 = 0.f;
#pragma unroll
            for (int k = 0; k < 32; ++k) { v[k] -= mean; q2 += v[k] * v[k]; }
            const float rstd = 1.0f / sqrtf(wave_sum(q2, lane) * (1.0f / DM) + LN_EPS);
#pragma unroll
            for (int j = 0; j < 2; ++j) { u32x4 hw;
#pragma unroll
                for (int q = 0; q < 4; ++q) { const int col = 16 * lane + 1024 * j + 4 * q;
                    const f32x4 la = *(const LAS f32x4*)(vlg + col), ba = *(const LAS f32x4*)(vlb + col);
                    f32x4 oa;
#pragma unroll
                    for (int t = 0; t < 4; ++t) oa[t] = v[16 * j + 4 * q + t] * rstd * la[t] + ba[t];
                    if (l == 0) *(u32x2*)((unsigned short*)(a.ws + WS_X1) + (size_t)T * DM + (size_t)row * DM + col) = (u32x2){pkh(oa[0], oa[1]), pkh(oa[2], oa[3])};
                    else *(f32x4*)(OUT + (size_t)row * DM + col) = oa;
                    if (l == 0) { const f32x4 sa = *(const LAS f32x4*)(vsc + col), ha = *(const LAS f32x4*)(vsh + col); const f32x4 h0 = oa * sa + ha;
                        const f32x4 hs = __builtin_elementwise_min(__builtin_elementwise_max(h0 * HIN1_SCALE, (f32x4){-448.f, -448.f, -448.f, -448.f}), (f32x4){448.f, 448.f, 448.f, 448.f});
                        unsigned w8; asm volatile("v_cvt_pk_fp8_f32 %0, %1, %2" : "=v"(w8) : "v"(hs[0]), "v"(hs[1])); asm volatile("v_cvt_pk_fp8_f32 %0, %1, %2 op_sel:[0,0,1]" : "+v"(w8) : "v"(hs[2]), "v"(hs[3])); hw[q] = w8; } }
                if (l == 0) *(u32x4*)((unsigned char*)HB + (size_t)row * DM + 16 * lane + 1024 * j) = hw; }
        }
    }
    if (l == 0) {
        __syncthreads();
        LAS float* scr = (LAS float*)(lds + wave * 16384);
        (void)scr;
    }
}

__device__ __forceinline__ Args load_args(unsigned long long kp) {
    const __attribute__((address_space(4))) Args* p = (const __attribute__((address_space(4))) Args*)kp;
    Args A;
#pragma unroll
    for (int i = 0; i < 17; ++i) A.in[i] = (const float*)(GAS const float*)(uintptr_t)p->in[i];
    A.out = (float*)(GAS float*)(uintptr_t)p->out; A.ws = (unsigned char*)(GAS unsigned char*)(uintptr_t)p->ws; A.ph_lo = p->ph_lo; A.ph_hi = p->ph_hi;
    return A;
}
constexpr int NPHASE = 22;
#ifndef PH_MASK
#define PH_MASK 0xFFF
#endif
#define PH_EN(k) ((((PH_MASK) >> (k)) & 1) != 0)

__global__ void __launch_bounds__(512, 2) fwd(Args args) {
    extern __shared__ __attribute__((aligned(16))) unsigned char lds_raw[];
    LAS unsigned char* lds = (LAS unsigned char*)lds_raw;
    const int tid0 = threadIdx.x; const int wave0 = __builtin_amdgcn_readfirstlane(tid0 >> 6);
#define LAUNDER() int tid = wave0 * 64 + ({ int l_; asm volatile("v_mbcnt_lo_u32_b32 %0, -1, 0\n\tv_mbcnt_hi_u32_b32 %0, -1, %0" : "=v"(l_)); l_; }); const int lane = tid & 63, wave = __builtin_amdgcn_readfirstlane(tid >> 6); (void)lane; (void)wave; LAUNDER_WS()
#define LAUNDER_WS() int bxl = bx, Gl = G; asm volatile("" : "+s"(bxl), "+s"(Gl)); const int vcul = (Gl % 8 == 0) ? (bxl % 8) * (Gl / 8) + bxl / 8 : bxl; (void)vcul; \
    unsigned long long kp_ = (unsigned long long)(uintptr_t)__builtin_amdgcn_kernarg_segment_ptr(); asm volatile("" : "+s"(kp_)); const Args A = load_args(kp_)
    const int G = gridDim.x; const int bx = blockIdx.x; const int vcu = (G % 8 == 0) ? (bx % 8) * (G / 8) + bx / 8 : bx;
    volatile LAS unsigned* MISC = (volatile LAS unsigned*)(lds + MISC_OFF);
    for (int u = tid0; u < (LDS_BYTES - RING_BYTES) / 4; u += 512) ((LAS unsigned*)(lds + RING_BYTES))[u] = 0u;
    __syncthreads();
    const int lo = args.ph_lo, hi = args.ph_hi;
    XcdBarrier bar; bar.bar = (unsigned*)(args.ws + WS_CTL) + CW_BAR; bar.x = 0; bar.st = nullptr;
    if (hi - lo > 1) bar = xcd_barrier_post((unsigned*)(args.ws + WS_CTL) + CW_BAR, MISC + 8);
#define IN(k) (lo <= (k) && (k) < hi)
#define BAR_SYNC() do { XcdBarrier b2_ = bar; { unsigned long long w_ = (unsigned long long)(uintptr_t)b2_.bar; asm volatile("" : "+s"(w_)); b2_.bar = (unsigned*)(GAS unsigned*)(uintptr_t)w_; } const int ln_ = ({ int l_; asm volatile("v_mbcnt_lo_u32_b32 %0, -1, 0\n\tv_mbcnt_hi_u32_b32 %0, -1, %0" : "=v"(l_)); l_; }); xcd_barrier(b2_, wave0 == 0 && ln_ == 0); } while (0)
#define SEAM(k) do { if (IN(k) && IN((k) + 1)) BAR_SYNC(); } while (0)

    for (int rep_ = 0; rep_ < PH_REP(0); ++rep_) if (PH_EN(0) && IN(0)) { if (rep_ > 0 && hi - lo > 1) BAR_SYNC(); LAUNDER(); phase_prologue(A, lds, tid, lane, wave, vcul, Gl, bxl); } SEAM(0);
    for (int rep_ = 0; rep_ < PH_REP(1); ++rep_) if (PH_EN(1) && IN(1)) { if (rep_ > 0 && hi - lo > 1) BAR_SYNC(); LAUNDER(); phase_modulate0(A, lane, wave, vcul, Gl); } SEAM(1);
    for (int l = 0; l < 2; ++l) {
        const int pb = 2 + 10 * l;
        for (int rep_ = 0; rep_ < PH_REP(2); ++rep_) if (PH_EN(2) && IN(pb + 0)) { if (rep_ > 0 && hi - lo > 1) BAR_SYNC();
            LAUNDER_WS(); const int N = l == 0 ? AB_IN : C_IN;
            pg8::StaticOrder S; S.init(T, C_IN, Gl, bxl);
            if (l == 0) { pg8::Gemm g{(const bf16_t*)(A.ws + WS_HB), (const bf16_t*)(A.ws + WS_WIN0), T, C_IN, DM, nullptr};
                pg8::EpiBf16 E{(bf16_t*)(A.ws + WS_R1), N, 0xFFFF, 1.0f};
                pg8::gemm_phase<pg8::EpiBf16, pg8::StaticOrder, true, true>(lds, g, S, E, wave0); }
            { pg8::Gemm g{(const bf16_t*)(A.ws + (l == 0 ? WS_R2 : WS_HB)), (const bf16_t*)(A.ws + (l == 0 ? WS_WIN0 + (size_t)3072 * DM * 2 : WS_WIN1)), T, C_IN, DM / 2, nullptr};
                pg8::EpiBf16 E{(bf16_t*)(A.ws + WS_R1) + (l == 0 ? 3072 : 0), N, 0xFFFF, 1.0f / (HIN1_SCALE * WIN1_SCALE)};
                pg8::gemm_phase<pg8::EpiBf16, pg8::StaticOrder, true, true, true>(lds, g, S, E, wave0); }
        } SEAM(pb + 0);
        for (int rep_ = 0; rep_ < PH_REP(3); ++rep_) if (PH_EN(3) && IN(pb + 1)) { if (rep_ > 0 && hi - lo > 1) BAR_SYNC(); for (int part_ = (l == 0 ? 1 : 3); part_ <= (l == 0 ? 2 : 3); ++part_) { if (part_ == 2) BAR_SYNC();     LAUNDER_WS(); phase_attention(A, l, lds, Gl, bxl, wave0, part_); } } SEAM(pb + 1);
        for (int rep_ = 0; rep_ < PH_REP(4); ++rep_) if (PH_EN(4) && IN(pb + 2) && l == 0) { if (rep_ > 0 && hi - lo > 1) BAR_SYNC(); LAUNDER(); phase_combine(A, l, lane, wave, vcul, Gl); } if (l == 0) SEAM(pb + 2);
        for (int rep_ = 0; rep_ < PH_REP(5); ++rep_) if (PH_EN(5) && IN(pb + 3)) { if (rep_ > 0 && hi - lo > 1) BAR_SYNC();
            LAUNDER_WS();
            pg8::StaticOrder S; S.init(T, DM, Gl, bxl);
            if (l == 0) { pg8::Gemm g{(const bf16_t*)(A.ws + WS_HB), (const bf16_t*)(A.ws + WS_WOUT0), T, DM, DM, nullptr};
                pg8::EpiBf16 E{(bf16_t*)(A.ws + WS_R3), DM, 0xFFFF, 1.0f};
                pg8::gemm_phase<pg8::EpiBf16, pg8::StaticOrder, true, true>(lds, g, S, E, wave0); }
            else { pg8::Gemm g{(const bf16_t*)(A.ws + WS_HB), (const bf16_t*)(A.ws + WS_WOUT1), T, DM, DM / 2, nullptr};
                pg8::EpiF8 E{(unsigned char*)(A.ws + WS_R3), DM, 0xFFFF, YO1_SCALE / (YATT_SCALE * WOUT_SCALE)};
                pg8::gemm_phase<pg8::EpiF8, pg8::StaticOrder, true, true, true>(lds, g, S, E, wave0); }
        } SEAM(pb + 3);
        for (int rep_ = 0; rep_ < PH_REP(6); ++rep_) if (PH_EN(6) && IN(pb + 4)) { if (rep_ > 0 && hi - lo > 1) BAR_SYNC(); LAUNDER(); phase_ln1_router(A, l, l == 0 ? A.in[IN_X] : (const float*)A.out, lds, tid, lane, wave, vcul, Gl); } SEAM(pb + 4);
        for (int rep_ = 0; rep_ < PH_REP(7); ++rep_) if (PH_EN(7) && IN(pb + 5)) { if (rep_ > 0 && hi - lo > 1) BAR_SYNC(); LAUNDER(); phase_topk(A, lds, tid, lane, wave, Gl, bxl); } SEAM(pb + 5);
        for (int rep_ = 0; rep_ < PH_REP(9); ++rep_) if (PH_EN(9) && IN(pb + 7)) { if (rep_ > 0 && hi - lo > 1) BAR_SYNC();
            LAUNDER_WS();
            pg8::Gemm g{(const bf16_t*)(A.ws + WS_HB), (const bf16_t*)(A.ws + WS_WGU), NSLOT, NE * 4096, DM / 2, (const unsigned*)(A.ws + WS_IDX)};
            pg8::GroupedOrder<16> S; S.init(Gl, bxl);
            pg8::EpiSwiGLU<true> E{(bf16_t*)(A.ws + WS_R2), EH, 15, HID_SCALE, 1.0f / (WGU_SCALE * H2_SCALE)};
            pg8::gemm_phase<pg8::EpiSwiGLU<true>, pg8::GroupedOrder<16>, true, true, true, true>(lds, g, S, E, wave0);
        } SEAM(pb + 7);
        for (int rep_ = 0; rep_ < PH_REP(10); ++rep_) if (PH_EN(10) && IN(pb + 8)) { if (rep_ > 0 && hi - lo > 1) BAR_SYNC();
            LAUNDER_WS();
            pg8::Gemm g{(const bf16_t*)(A.ws + WS_R2), (const bf16_t*)(A.ws + WS_WDN), NSLOT, NE * DM, EH / 2, nullptr};
            pg8::GroupedOrder<8> S; S.init(Gl, bxl);
            pg8::EpiF8 E{(unsigned char*)(A.ws + WS_R3), DM, 7, YD_SCALE / (WDN_SCALE * HID_SCALE)};
            pg8::gemm_phase<pg8::EpiF8, pg8::GroupedOrder<8>, true, true, true>(lds, g, S, E, wave0);
        } SEAM(pb + 8);
        for (int rep_ = 0; rep_ < PH_REP(11); ++rep_) if (PH_EN(11) && IN(pb + 9)) { if (rep_ > 0 && hi - lo > 1) BAR_SYNC(); LAUNDER(); phase_ffn_combine(A, l, A.out, lds, tid, lane, wave, vcul, Gl); } SEAM(pb + 9);
    }
#undef IN
#undef SEAM
#undef BAR_SYNC
}

extern "C" void kernel_launch(void* const* d_in, const int* in_sizes, int n_in, void* d_out, int out_size, void* d_ws, size_t ws_size, hipStream_t stream) {
    static int grid = 0;
    if (grid == 0) {
        if (n_in != 17 || out_size != T * DM || ws_size < WS_END) { fprintf(stderr, "kernel_launch: unexpected shapes (n_in %d out %d ws %zu, need ws >= %zu)\n", n_in, out_size, ws_size, (size_t)WS_END); grid = -1; return; }
        int dev = 0, cus = 0, per_cu = 0;
        if (hipGetDevice(&dev) != hipSuccess || hipDeviceGetAttribute(&cus, hipDeviceAttributeMultiprocessorCount, dev) != hipSuccess) { grid = -1; return; }
        if (hipFuncSetAttribute((const void*)fwd, hipFuncAttributeMaxDynamicSharedMemorySize, LDS_BYTES) != hipSuccess) { fprintf(stderr, "kernel_launch: hipFuncSetAttribute failed\n"); grid = -1; return; }
        if (hipOccupancyMaxActiveBlocksPerMultiprocessor(&per_cu, (const void*)fwd, 512, LDS_BYTES) != hipSuccess || per_cu < 1) fprintf(stderr, "kernel_launch: occupancy query says %d\n", per_cu);
        (void)hipGetLastError();
        grid = cus;
    }
    if (grid < 0) return;
    (void)hipMemsetAsync((char*)d_ws + WS_CTL, 0, CTL_ZERO_BYTES, stream);
    Args a{};
    for (int i = 0; i < 17; ++i) a.in[i] = (const float*)d_in[i];
    a.out = (float*)d_out; a.ws = (unsigned char*)d_ws;
#if MK_SINGLE
    a.ph_lo = 0; a.ph_hi = NPHASE;
    hipLaunchKernelGGL(fwd, dim3(grid), dim3(512), LDS_BYTES, stream, a);
#else
    for (int p = 0; p < NPHASE; ++p) { a.ph_lo = p; a.ph_hi = p + 1; hipLaunchKernelGGL(fwd, dim3(grid), dim3(512), LDS_BYTES, stream, a); }
#endif
}
```

```cpp
#include <hip/hip_runtime.h>
#include <cstdio>
#include <cstdint>
#ifndef MK_SINGLE
#define MK_SINGLE 1
#endif
namespace pg8 {
#define PG8_LAS __attribute__((address_space(3)))
typedef unsigned short bf16_t;
typedef short bf16x8 __attribute__((ext_vector_type(8)));
typedef float f32x4 __attribute__((ext_vector_type(4)));
typedef unsigned u32x4 __attribute__((ext_vector_type(4)));
typedef int i32x4 __attribute__((ext_vector_type(4)));
typedef int i32x8 __attribute__((ext_vector_type(8)));
constexpr int BM = 256, BK = 64, HALF = 128, HTB = HALF * BK * 2  , STAGE_BYTES = 8 * HTB, NXCD = 8, WGM = 8;

__host__ __device__ __forceinline__ int lds_byte(int r, int c) { const int st = (r >> 4) * 2 + (c >> 5), rr = r & 15, cc = c & 31, ob = rr * 64 + cc * 2; return st * 1024 + (ob ^ (((ob >> 9) & 1) << 5)); }
__host__ __device__ __forceinline__ void stage_rc(int b, int& R, int& C) { const int st = b / 1024, sb = b % 1024, swz = sb ^ (((sb >> 9) & 1) << 5); R = (st >> 1) * 16 + swz / 64; C = (st & 1) * 32 + (swz % 64) / 2; }
__host__ __device__ __forceinline__ int perm32(int rho) { const int n = rho >> 4, i = rho & 15; return 8 * (i >> 2) + 4 * n + (i & 3); }

struct Unit { int pm, pn; };
struct Gemm { const bf16_t* A; const bf16_t* Bt; int M, N, K; const unsigned* rowoff; };

struct StaticOrder {
    int nM, nN, nwg, G, c;
    __host__ __device__ void init(int M, int N, int G_, int c_) { nM = M / BM; nN = N / BM; nwg = nM * nN; G = G_; c = c_; }
    __host__ __device__ bool next(int i, Unit& u) const {
        const long L = (long)i * G + c; if (L >= nwg) return false;
        int wgid = (int)L; { const int q = nwg / NXCD, r = nwg % NXCD, xcd = wgid % NXCD, off = wgid / NXCD; wgid = (xcd < r ? xcd * (q + 1) : r * (q + 1) + (xcd - r) * q) + off; }
        const int nig = WGM * nN, gid = wgid / nig, fm = gid * WGM, gsz = (nM - fm) < WGM ? (nM - fm) : WGM;
        u.pm = fm + ((wgid % nig) % gsz); u.pn = (wgid % nig) / gsz; return true;
    }
    __device__ __forceinline__ void a_ready(const Unit&) const {}
    __device__ __forceinline__ void done(const Unit&) const {}
};

__device__ __forceinline__ unsigned cvt_pk_bf16(float lo, float hi) { unsigned r; asm volatile("v_cvt_pk_bf16_f32 %0, %1, %2" : "=v"(r) : "v"(lo), "v"(hi)); return r; }
typedef float f32x2 __attribute__((ext_vector_type(2)));

struct EpiBf16 {
    static constexpr bool PERM = true, AFTER_DRAIN = false;
    bf16_t* O; int ldc; int pnmask; float oscale;
    __device__ __forceinline__ void operator()(const f32x4 (&acc)[2][2][4][2], const Unit& u, int wr, int wc, int fr, int fq) const {
        const int row0 = u.pm * BM + wr * 64 + fr; const int col0 = (u.pn & pnmask) * BM + wc * 32 + 8 * fq;
#pragma unroll
        for (int ai = 0; ai < 2; ++ai)
#pragma unroll
            for (int m = 0; m < 4; ++m) { bf16_t* rowp = O + (size_t)(row0 + ai * HALF + m * 16) * ldc + col0;
#pragma unroll
                for (int bj = 0; bj < 2; ++bj) { const f32x4 v0 = acc[ai][bj][m][0] * oscale, v1 = acc[ai][bj][m][1] * oscale;
                    u32x4 w; w.x = cvt_pk_bf16(v0[0], v0[1]); w.y = cvt_pk_bf16(v0[2], v0[3]); w.z = cvt_pk_bf16(v1[0], v1[1]); w.w = cvt_pk_bf16(v1[2], v1[3]);
                    *(u32x4*)(rowp + bj * HALF) = w; } }
    }
};
struct EpiF8 {
    static constexpr bool PERM = true, AFTER_DRAIN = false;
    unsigned char* O; int ldc; int pnmask; float oscale;
    __device__ __forceinline__ void operator()(const f32x4 (&acc)[2][2][4][2], const Unit& u, int wr, int wc, int fr, int fq) const {
        const int row0 = u.pm * BM + wr * 64 + fr; const int col0 = (u.pn & pnmask) * BM + wc * 32 + 8 * fq;
        typedef int i32x2 __attribute__((ext_vector_type(2)));
#pragma unroll
        for (int ai = 0; ai < 2; ++ai)
#pragma unroll
            for (int m = 0; m < 4; ++m) { unsigned char* rowp = O + (size_t)(row0 + ai * HALF + m * 16) * ldc + col0;
#pragma unroll
                for (int bj = 0; bj < 2; ++bj) { const f32x4 lo4 = {-448.f, -448.f, -448.f, -448.f}, hi4 = {448.f, 448.f, 448.f, 448.f};
                    const f32x4 v0 = __builtin_elementwise_min(__builtin_elementwise_max(acc[ai][bj][m][0] * oscale, lo4), hi4), v1 = __builtin_elementwise_min(__builtin_elementwise_max(acc[ai][bj][m][1] * oscale, lo4), hi4);
                    int w0 = __builtin_amdgcn_cvt_pk_fp8_f32(v0[0], v0[1], 0, false); w0 = __builtin_amdgcn_cvt_pk_fp8_f32(v0[2], v0[3], w0, true);
                    int w1 = __builtin_amdgcn_cvt_pk_fp8_f32(v1[0], v1[1], 0, false); w1 = __builtin_amdgcn_cvt_pk_fp8_f32(v1[2], v1[3], w1, true);
                    *(i32x2*)(rowp + bj * HALF) = (i32x2){w0, w1}; } }
    }
};
template <bool F8OUT> struct EpiSwiGLU {
    static constexpr bool PERM = true, AFTER_DRAIN = false;
    bf16_t* O; int ldc; int pnmask; float oscale; float iscale;
    __device__ __forceinline__ static float silu_mul(float g, float u) { const float e = __builtin_amdgcn_exp2f(-1.4426950408889634f * g); return g * __builtin_amdgcn_rcpf(1.0f + e) * u; }
    __device__ __forceinline__ void operator()(const f32x4 (&acc)[2][2][4][2], const Unit& u, int wr, int wc, int fr, int fq) const {
        const int row0 = u.pm * BM + wr * 64 + fr; const int col0 = (u.pn & pnmask) * HALF + wc * 32 + 8 * fq;
#pragma unroll
        for (int ai = 0; ai < 2; ++ai)
#pragma unroll
            for (int m = 0; m < 4; ++m) { bf16_t* rowp = O + (size_t)(row0 + ai * HALF + m * 16) * ldc + col0;
                if constexpr (F8OUT) {
                    float h[8]; const float kt = -1.4426950408889634f * iscale, kd = 1.0f / (iscale * iscale * oscale);
#pragma unroll
                    for (int n = 0; n < 2; ++n) { const f32x4 G = acc[ai][0][m][n], U = acc[ai][1][m][n];
#pragma unroll
                        for (int hh = 0; hh < 2; ++hh) { const f32x2 gg = {G[2 * hh], G[2 * hh + 1]}, uu = {U[2 * hh], U[2 * hh + 1]};
                            const f32x2 t = gg * kt; f32x2 e; e.x = __builtin_amdgcn_exp2f(t.x); e.y = __builtin_amdgcn_exp2f(t.y);
                            const f32x2 d = e * kd + kd; f32x2 r; r.x = __builtin_amdgcn_rcpf(d.x); r.y = __builtin_amdgcn_rcpf(d.y);
                            const f32x2 p = (gg * uu) * r;
                            h[4 * n + 2 * hh] = __builtin_fminf(__builtin_fmaxf(p.x, -448.f), 448.f); h[4 * n + 2 * hh + 1] = __builtin_fminf(__builtin_fmaxf(p.y, -448.f), 448.f); } }
                    int w0 = __builtin_amdgcn_cvt_pk_fp8_f32(h[0], h[1], 0, false); w0 = __builtin_amdgcn_cvt_pk_fp8_f32(h[2], h[3], w0, true);
                    int w1 = __builtin_amdgcn_cvt_pk_fp8_f32(h[4], h[5], 0, false); w1 = __builtin_amdgcn_cvt_pk_fp8_f32(h[6], h[7], w1, true);
                    typedef int i32x2 __attribute__((ext_vector_type(2)));
                    *(i32x2*)((unsigned char*)O + (size_t)(row0 + ai * HALF + m * 16) * ldc + col0) = (i32x2){w0, w1};
                } else {
                const f32x4 g0 = acc[ai][0][m][0] * iscale, g1 = acc[ai][0][m][1] * iscale, u0 = acc[ai][1][m][0] * iscale, u1 = acc[ai][1][m][1] * iscale;
                u32x4 w; w.x = cvt_pk_bf16(silu_mul(g0[0], u0[0]), silu_mul(g0[1], u0[1])); w.y = cvt_pk_bf16(silu_mul(g0[2], u0[2]), silu_mul(g0[3], u0[3]));
                w.z = cvt_pk_bf16(silu_mul(g1[0], u1[0]), silu_mul(g1[1], u1[1])); w.w = cvt_pk_bf16(silu_mul(g1[2], u1[2]), silu_mul(g1[3], u1[3]));
                *(u32x4*)rowp = w; } }
    }
};
struct EpiF32 {
    static constexpr bool PERM = false, AFTER_DRAIN = false;
    float* O; int ldc;
    __device__ __forceinline__ void operator()(const f32x4 (&acc)[2][2][4][2], const Unit& u, int wr, int wc, int fr, int fq) const {
        const int row0 = u.pm * BM + wr * 64 + fr; const int col0 = u.pn * BM + wc * 32 + 4 * fq;
#pragma unroll
        for (int ai = 0; ai < 2; ++ai)
#pragma unroll
            for (int m = 0; m < 4; ++m) { float* rowp = O + (size_t)(row0 + ai * HALF + m * 16) * ldc + col0;
#pragma unroll
                for (int bj = 0; bj < 2; ++bj)
#pragma unroll
                    for (int n = 0; n < 2; ++n) *(f32x4*)(rowp + bj * HALF + n * 16) = acc[ai][bj][m][n]; }
    }
};
template <int NNL> struct GroupedOrder {
    int G, c;
    __device__ void init(int G_, int c_) { G = G_; c = c_; }
    __device__ bool next(int i, Unit& u) const {
        const int L = i * G + c; if (L >= 16 * 16 * NNL) return false;
        const int rnd = L >> 8, w = L & 255, x = w & 7, j = w >> 3;
        int e, rt, ct;
        if (NNL == 16) { e = rnd; rt = 4 * (x >> 1) + (j & 3); ct = 8 * (x & 1) + (j >> 2); }
        else           { e = 2 * rnd + (x >> 2); rt = 4 * (x & 3) + (j & 3); ct = j >> 2; }
        const int b = rt >> 1, half = rt & 1;
        u.pm = (b * 16 + e) * 2 + half; u.pn = e * NNL + ct; return true;
    }
    __device__ __forceinline__ void a_ready(const Unit&) const {}
    __device__ __forceinline__ void done(const Unit&) const {}
};
template <class Epi, class Sched, bool ALIGN_EPI = false, bool SP2 = false, bool F8 = false, bool GA = false>
__device__ __forceinline__ void gemm_phase(PG8_LAS unsigned char* lds, const Gemm g, const Sched& S, const Epi& E, const int wave0  ) {
    int tid = wave0 * 64 + ({ int l_; asm volatile("v_mbcnt_lo_u32_b32 %0, -1, 0\n\tv_mbcnt_hi_u32_b32 %0, -1, %0" : "=v"(l_)); l_; });
    const int wid = __builtin_amdgcn_readfirstlane(tid >> 6), lane = tid & 63, wr = wid >> 2, wc = wid & 3, fr = lane & 15, fq = lane >> 4;
    const int K = g.K, nt = K / BK;
    unsigned voffA[2], voffB[2];
#pragma unroll
    for (int i = 0; i < 2; ++i) { int R, C; stage_rc(tid * 16 + i * 8192, R, C); const int Rb = Epi::PERM ? ((R & ~31) + perm32(R & 31)) : R;
        voffA[i] = (unsigned)(R * K + C) * 2u; voffB[i] = (unsigned)(Rb * K + C) * 2u; }
    const size_t kstep = (size_t)(BK * 2);
    const size_t hstep = (size_t)HALF * K * 2;
    const size_t tstep = 2 * hstep;
    const size_t hstepA = GA ? 0 : hstep, tstepA = GA ? 0 : tstep;
    const unsigned ldsw = (unsigned)wid * 1024u;
    const int aoff = lds_byte(wr * 64 + fr, fq * 8), boff = lds_byte(wc * 32 + fr, fq * 8);
#define PG8_SA(b, h) (((b) * 2 + (h)) * HTB)
#define PG8_SB(b, h) ((4 + (b) * 2 + (h)) * HTB)
    const __amdgpu_buffer_rsrc_t rsA = __builtin_amdgcn_make_buffer_rsrc((void*)g.A, 0, 0x7FFFFFFF, 0x00020000), rsB = __builtin_amdgcn_make_buffer_rsrc((void*)g.Bt, 0, 0x7FFFFFFF, 0x00020000);
#define PG8_STAGE_X(rs, base0, bufoff, gbase, voff) do { const int so_ = (int)((const char*)(gbase) - (const char*)(base0)); _Pragma("unroll") for (int _i = 0; _i < 2; ++_i) \
        __builtin_amdgcn_raw_ptr_buffer_load_lds(rs, (PG8_LAS void*)(lds + (bufoff) + ldsw + _i * 8192), 16, (int)(voff)[_i], so_, 0, 0); } while (0)
#define PG8_STAGE_A(bufoff, gbase, voff) PG8_STAGE_X(rsA, g.A, bufoff, gbase, voff)
    static_assert(!GA || SP2, "gathered A rows: SP2 loop only");
    unsigned vg[2][2], vgn[2][2]; int gR[2]; unsigned gC[2]; constexpr int GA_LDS_OFF = 132096;
    const __amdgpu_buffer_rsrc_t rsR = __builtin_amdgcn_make_buffer_rsrc((void*)(GA ? (const void*)g.rowoff : (const void*)g.A), 0, 0x7FFFFFFF, 0x00020000);
    if constexpr (GA) {
#pragma unroll
        for (int i = 0; i < 2; ++i) { int R, C; stage_rc(tid * 16 + i * 8192, R, C); gR[i] = R; gC[i] = (unsigned)C * 2u; } }
#define PG8_STA(bufoff, h, nx, gbase) do { if constexpr (GA) { const int so_ = (int)((const char*)(gbase) - (const char*)g.A); _Pragma("unroll") for (int _i = 0; _i < 2; ++_i) \
            __builtin_amdgcn_raw_ptr_buffer_load_lds(rsA, (PG8_LAS void*)(lds + (bufoff) + ldsw + _i * 8192), 16, (int)((nx) ? vgn[h][_i] : vg[h][_i]), so_, 0, 0); } \
        else PG8_STAGE_X(rsA, g.A, bufoff, gbase, voffA); } while (0)
#define PG8_STAGE_B(bufoff, gbase, voff) PG8_STAGE_X(rsB, g.Bt, bufoff, gbase, voff)
#define PG8_LDA(dst, b, h) do { if constexpr (F8) { _Pragma("unroll") for (int m = 0; m < 4; ++m) { const i32x4 lo_ = *(const PG8_LAS i32x4*)(lds + PG8_SA(b, h) + aoff + m * 2048), hi_ = *(const PG8_LAS i32x4*)(lds + PG8_SA(b, h) + aoff + m * 2048 + 1024); \
            dst##8[m] = __builtin_shufflevector(lo_, hi_, 0, 1, 2, 3, 4, 5, 6, 7); } } \
        else { _Pragma("unroll") for (int m = 0; m < 4; ++m) _Pragma("unroll") for (int k = 0; k < 2; ++k) dst[m][k] = *(const PG8_LAS bf16x8*)(lds + PG8_SA(b, h) + aoff + m * 2048 + k * 1024); } } while (0)
#define PG8_LDB(dst, b, h) do { if constexpr (F8) { _Pragma("unroll") for (int n = 0; n < 2; ++n) { const i32x4 lo_ = *(const PG8_LAS i32x4*)(lds + PG8_SB(b, h) + boff + n * 2048), hi_ = *(const PG8_LAS i32x4*)(lds + PG8_SB(b, h) + boff + n * 2048 + 1024); \
            dst##8[n] = __builtin_shufflevector(lo_, hi_, 0, 1, 2, 3, 4, 5, 6, 7); } } \
        else { _Pragma("unroll") for (int n = 0; n < 2; ++n) _Pragma("unroll") for (int k = 0; k < 2; ++k) dst[n][k] = *(const PG8_LAS bf16x8*)(lds + PG8_SB(b, h) + boff + n * 2048 + k * 1024); } } while (0)
#define PG8_MMA(ai, bj, At, Bt) do { __builtin_amdgcn_s_setprio(1); \
        if constexpr (F8) { _Pragma("unroll") for (int m = 0; m < 4; ++m) _Pragma("unroll") for (int n = 0; n < 2; ++n) \
            asm volatile("v_mfma_f32_16x16x128_f8f6f4 %0, %1, %2, %0" : "+v"(acc[ai][bj][m][n]) : "v"(Bt##8[n]), "v"(At##8[m])); }   \
        else { _Pragma("unroll") for (int m = 0; m < 4; ++m) _Pragma("unroll") for (int n = 0; n < 2; ++n) _Pragma("unroll") for (int k = 0; k < 2; ++k) \
            acc[ai][bj][m][n] = __builtin_amdgcn_mfma_f32_16x16x32_bf16(Bt[n][k], At[m][k], acc[ai][bj][m][n], 0, 0, 0); } \
        __builtin_amdgcn_s_setprio(0); } while (0)
#define PG8_WAIT_V(n) asm volatile("s_waitcnt vmcnt(" #n ")" ::: "memory")
#define PG8_WAIT_L(n) asm volatile("s_waitcnt lgkmcnt(" #n ")" ::: "memory")
#define PG8_BAR __builtin_amdgcn_s_barrier()
#define PG8_SCHED __builtin_amdgcn_sched_barrier(0)
    Unit cur, nxt; int ui = 0;
    if (!S.next(0, cur)) return;
    f32x4 acc[2][2][4][2];
#pragma unroll
    for (int a = 0; a < 2; ++a)
#pragma unroll
        for (int b = 0; b < 2; ++b)
#pragma unroll
            for (int m = 0; m < 4; ++m)
#pragma unroll
                for (int n = 0; n < 2; ++n) acc[a][b][m][n] = (f32x4){0.f, 0.f, 0.f, 0.f};
    bf16x8 At[4][2], B0[2][2], B1[2][2]; i32x8 At8[4], B08[2], B18[2];
    const char* cA = (const char*)g.A + (size_t)cur.pm * tstepA; const char* cB = (const char*)g.Bt + (size_t)cur.pn * tstep;
    if constexpr (GA) {
#pragma unroll
        for (int h = 0; h < 2; ++h)
#pragma unroll
            for (int i = 0; i < 2; ++i) vg[h][i] = g.rowoff[cur.pm * BM + h * HALF + gR[i]] + gC[i]; }
    S.a_ready(cur);
    if constexpr (SP2) {
        PG8_STAGE_B(PG8_SB(0, 0), cB, voffB); PG8_STAGE_B(PG8_SB(0, 1), cB + hstep, voffB); PG8_STA(PG8_SA(0, 0), 0, false, cA); PG8_STA(PG8_SA(0, 1), 1, false, cA + hstepA);
        if (wr == 1) PG8_BAR;
        PG8_WAIT_V(2); PG8_BAR;
        PG8_STAGE_B(PG8_SB(1, 0), cB + kstep, voffB); PG8_STA(PG8_SA(1, 0), 0, false, cA + kstep); PG8_STAGE_B(PG8_SB(1, 1), cB + hstep + kstep, voffB);
        PG8_WAIT_V(6); PG8_BAR;
    } else {
        PG8_STAGE_B(PG8_SB(0, 0), cB, voffB); PG8_STAGE_A(PG8_SA(0, 0), cA, voffA); PG8_STAGE_B(PG8_SB(0, 1), cB + hstep, voffB); PG8_STAGE_A(PG8_SA(0, 1), cA + hstep, voffA);
        if (wr == 1) PG8_BAR;
        PG8_WAIT_V(4); PG8_BAR;
        PG8_STAGE_B(PG8_SB(1, 0), cB + kstep, voffB); PG8_STAGE_A(PG8_SA(1, 0), cA + kstep, voffA); PG8_STAGE_B(PG8_SB(1, 1), cB + hstep + kstep, voffB);
        PG8_WAIT_V(6); PG8_BAR;
    }
    for (;;) {
        const bool has_next = S.next(ui + 1, nxt);
        if constexpr (GA) { if (has_next && wid < 4)
            __builtin_amdgcn_raw_ptr_buffer_load_lds(rsR, (PG8_LAS void*)(lds + GA_LDS_OFF + (ui & 1) * 1024 + wid * 256), 4, tid * 4, nxt.pm * (BM * 4), 0, 0); }
        const char* nA = has_next ? (const char*)g.A + (size_t)nxt.pm * tstepA : cA; const char* nB = has_next ? (const char*)g.Bt + (size_t)nxt.pn * tstep : cB;
        for (int t = 0; t < nt; t += 2) {
            const bool last = (t == nt - 2);
            const char* a1 = cA + (size_t)(t + 1) * kstep;
            const char* a2 = last ? nA : cA + (size_t)(t + 2) * kstep; const char* b2 = last ? nB : cB + (size_t)(t + 2) * kstep;
            const char* a3 = a2 + kstep; const char* b3 = b2 + kstep;
            if (last && has_next) S.a_ready(nxt);
            if constexpr (GA) { if (last) {
#pragma unroll
                for (int h = 0; h < 2; ++h)
#pragma unroll
                    for (int i = 0; i < 2; ++i) vgn[h][i] = has_next ? *(const PG8_LAS unsigned*)(lds + GA_LDS_OFF + (ui & 1) * 1024 + (h * HALF + gR[i]) * 4) + gC[i] : vg[h][i]; } }
            if constexpr (SP2) {
            PG8_LDB(B0, 0, 0); PG8_LDB(B1, 0, 1); PG8_SCHED; PG8_LDA(At, 0, 0); PG8_STA(PG8_SA(1, 1), 1, false, a1 + hstepA);
            PG8_WAIT_V(8); PG8_WAIT_L(0); PG8_BAR; PG8_MMA(0, 0, At, B0); PG8_MMA(0, 1, At, B1); PG8_BAR; PG8_SCHED;
            PG8_LDA(At, 0, 1); PG8_STAGE_B(PG8_SB(0, 0), b2, voffB); PG8_STAGE_B(PG8_SB(0, 1), b2 + hstep, voffB); PG8_STA(PG8_SA(0, 0), 0, last, a2);
            PG8_WAIT_V(8); PG8_WAIT_L(0); PG8_BAR; PG8_MMA(1, 0, At, B0); PG8_MMA(1, 1, At, B1); PG8_BAR; PG8_SCHED;
            PG8_LDB(B0, 1, 0); PG8_LDB(B1, 1, 1); PG8_SCHED; PG8_LDA(At, 1, 0); PG8_STA(PG8_SA(0, 1), 1, last, a2 + hstepA);
            PG8_WAIT_V(8); PG8_WAIT_L(0); PG8_BAR; PG8_MMA(0, 0, At, B0); PG8_MMA(0, 1, At, B1); PG8_BAR; PG8_SCHED;
            PG8_LDA(At, 1, 1); PG8_STAGE_B(PG8_SB(1, 0), b3, voffB); PG8_STAGE_B(PG8_SB(1, 1), b3 + hstep, voffB); PG8_STA(PG8_SA(1, 0), 0, last, a3);
            PG8_WAIT_V(8); PG8_WAIT_L(0); PG8_BAR; PG8_MMA(1, 0, At, B0); PG8_MMA(1, 1, At, B1); PG8_BAR; PG8_SCHED;
            } else {
            PG8_LDB(B0, 0, 0); PG8_SCHED; PG8_LDA(At, 0, 0); PG8_STAGE_A(PG8_SA(1, 1), a1 + hstep, voffA);
            PG8_WAIT_L(8); PG8_BAR; PG8_WAIT_L(0); PG8_MMA(0, 0, At, B0); PG8_BAR; PG8_SCHED;
            PG8_LDB(B1, 0, 1); PG8_STAGE_B(PG8_SB(0, 0), b2, voffB);
            PG8_BAR; PG8_WAIT_L(0); PG8_MMA(0, 1, At, B1); PG8_BAR;
            PG8_LDA(At, 0, 1); PG8_STAGE_A(PG8_SA(0, 0), a2, voffA);
            PG8_BAR; PG8_WAIT_L(0); PG8_MMA(1, 0, At, B0); PG8_BAR; PG8_SCHED;
            PG8_STAGE_B(PG8_SB(0, 1), b2 + hstep, voffB);
            PG8_WAIT_V(6); PG8_BAR; PG8_MMA(1, 1, At, B1); PG8_BAR;
            PG8_LDB(B0, 1, 0); PG8_SCHED; PG8_LDA(At, 1, 0); PG8_STAGE_A(PG8_SA(0, 1), a2 + hstep, voffA);
            PG8_WAIT_L(8); PG8_BAR; PG8_WAIT_L(0); PG8_MMA(0, 0, At, B0); PG8_BAR; PG8_SCHED;
            PG8_LDB(B1, 1, 1); PG8_STAGE_B(PG8_SB(1, 0), b3, voffB);
            PG8_BAR; PG8_WAIT_L(0); PG8_MMA(0, 1, At, B1); PG8_BAR;
            PG8_LDA(At, 1, 1); PG8_STAGE_A(PG8_SA(1, 0), a3, voffA);
            PG8_BAR; PG8_WAIT_L(0); PG8_MMA(1, 0, At, B0); PG8_BAR; PG8_SCHED;
            PG8_STAGE_B(PG8_SB(1, 1), b3 + hstep, voffB);
            PG8_WAIT_V(6); PG8_BAR; PG8_MMA(1, 1, At, B1); PG8_BAR;
            }
        }
        if constexpr (F8) asm volatile("s_nop 15\n\ts_nop 15" ::: "memory");
        if constexpr (ALIGN_EPI) { if (wr == 0) PG8_BAR; }
        if constexpr (!Epi::AFTER_DRAIN) { E(acc, cur, wr, wc, fr, fq); S.done(cur); }
        if (!has_next) break;
#pragma unroll
        for (int a = 0; a < 2; ++a)
#pragma unroll
            for (int b = 0; b < 2; ++b)
#pragma unroll
                for (int m = 0; m < 4; ++m)
#pragma unroll
                    for (int n = 0; n < 2; ++n) acc[a][b][m][n] = (f32x4){0.f, 0.f, 0.f, 0.f};
        cur = nxt; cA = nA; cB = nB; ++ui;
        if constexpr (GA) {
#pragma unroll
            for (int h = 0; h < 2; ++h)
#pragma unroll
                for (int i = 0; i < 2; ++i) vg[h][i] = vgn[h][i]; }
        if constexpr (ALIGN_EPI) { if (wr == 1) PG8_BAR; }
    }
    PG8_WAIT_V(0);
    if constexpr (!ALIGN_EPI) { if (wr == 0) PG8_BAR; }
    PG8_BAR;
    if constexpr (Epi::AFTER_DRAIN) { E.fused(acc, cur, wr, wc, fr, fq, lds, wid, lane); S.done(cur); }
#undef PG8_SA
#undef PG8_SB
#undef PG8_STAGE_X
#undef PG8_STAGE_A
#undef PG8_STA
#undef PG8_STAGE_B
#undef PG8_LDA
#undef PG8_LDB
#undef PG8_MMA
#undef PG8_WAIT_V
#undef PG8_WAIT_L
#undef PG8_BAR
#undef PG8_SCHED
}
}

#define GAS __attribute__((address_space(1)))
#define LAS __attribute__((address_space(3)))
typedef unsigned short bf16_t;
typedef float f32x4 __attribute__((ext_vector_type(4)));
typedef float f32x2 __attribute__((ext_vector_type(2)));
typedef float f32x16 __attribute__((ext_vector_type(16)));
typedef unsigned u32x4 __attribute__((ext_vector_type(4)));
typedef unsigned u32x2 __attribute__((ext_vector_type(2)));
typedef short bf16x8 __attribute__((ext_vector_type(8)));
typedef short s16x4 __attribute__((ext_vector_type(4)));
typedef GAS unsigned gu32;
#define RLX_AGENT __ATOMIC_RELAXED, __HIP_MEMORY_SCOPE_AGENT
#define LDS_WAIT() asm volatile("s_waitcnt lgkmcnt(0)" ::: "memory")
#define VM_WAIT() asm volatile("s_waitcnt vmcnt(0)" ::: "memory")
__device__ __forceinline__ unsigned cvtpk(float lo, float hi) { unsigned r; asm volatile("v_cvt_pk_bf16_f32 %0, %1, %2" : "=v"(r) : "v"(lo), "v"(hi)); return r; }
__device__ __forceinline__ float bf_lo(unsigned w) { return __uint_as_float(w << 16); }
typedef __fp16 f16x2_t __attribute__((__vector_size__(2 * sizeof(__fp16))));
__device__ __forceinline__ unsigned pkh(float lo, float hi) { return __builtin_bit_cast(unsigned, __builtin_amdgcn_cvt_pkrtz(lo, hi)); }
__device__ __forceinline__ float h_lo(unsigned w) { return (float)__builtin_bit_cast(f16x2_t, w)[0]; }
__device__ __forceinline__ float h_hi(unsigned w) { return (float)__builtin_bit_cast(f16x2_t, w)[1]; }
__device__ __forceinline__ float bf_hi(unsigned w) { return __uint_as_float(w & 0xffff0000u); }
__device__ __forceinline__ float shx(float v, int mask, int lane) { return __int_as_float(__builtin_amdgcn_ds_bpermute((lane ^ mask) << 2, __float_as_int(v))); }
__device__ __forceinline__ int shup_i(int v, int o, int lane) { return __builtin_amdgcn_ds_bpermute(((lane - o) & 63) << 2, v); }
__device__ __forceinline__ float wave_sum(float v, int lane) {
#pragma unroll
    for (int o = 1; o < 64; o <<= 1) v += shx(v, o, lane);
    return v;
}

#ifndef REP_MASK
#define REP_MASK 0
#endif
#ifndef REP_N
#define REP_N 1
#endif
#define PH_REP(k) (1 + REP_N * (((REP_MASK) >> (k)) & 1))
template <int CTRL> __device__ __forceinline__ float dpp_mov(float v) { return __int_as_float(__builtin_amdgcn_update_dpp(0, __float_as_int(v), CTRL, 0xF, 0xF, true)); }
__device__ __forceinline__ float sum8_dpp(float v) { v += dpp_mov<0xB1>(v); v += dpp_mov<0x4E>(v); v += dpp_mov<0x141>(v); return v; }
__device__ __forceinline__ float swap16_add(float a, float b) { auto r = __builtin_amdgcn_permlane16_swap(__float_as_uint(a), __float_as_uint(b), false, false); return __uint_as_float(r[0]) + __uint_as_float(r[1]); }
__device__ __forceinline__ float swap32_add(float a, float b) { auto r = __builtin_amdgcn_permlane32_swap(__float_as_uint(a), __float_as_uint(b), false, false); return __uint_as_float(r[0]) + __uint_as_float(r[1]); }
__device__ __forceinline__ float wave_sum_v(float v) { v = sum8_dpp(v); v += dpp_mov<0x128>(v); v = swap16_add(v, v); return swap32_add(v, v); }
constexpr int DM = 2048, NB = 8, SEQ = 4096, T = NB * SEQ, HD = 128;
constexpr int AB_IN = 6144, C_IN = 3072, NE = 16, EH = 2048, CAP = 512, NSLOT = NB * NE * CAP;
constexpr float ALPHA = 1.4142135623730951f, LN_EPS = 1e-5f;
constexpr float SCALE = 0.088388347648318440f;
constexpr float LAM_INIT0 = 0.2f;
constexpr float WDN_SCALE = 128.f, HID_SCALE = 8.f, WGU_SCALE = 64.f, H2_SCALE = 4.f, YD_SCALE = 16.f;
constexpr float HIN1_SCALE = 16.f, WIN1_SCALE = 512.f;
constexpr float YO1_SCALE = 256.f;
constexpr float YATT_SCALE = 32.f, WOUT_SCALE = 128.f;

constexpr size_t MiB = 1u << 20;
constexpr size_t WS_CTL = 0, CTL_ZERO_BYTES = 1 * MiB;
constexpr size_t WS_MOD = 1 * MiB;
constexpr size_t WS_AFF = 2 * MiB;
constexpr size_t WS_IDX = 4 * MiB;
constexpr size_t WS_INVC = 5 * MiB;
constexpr size_t WS_INVG = 7 * MiB;
constexpr size_t WS_LSE = 9 * MiB;
constexpr size_t WS_WIN0 = 12 * MiB, WS_WIN1 = 36 * MiB, WS_WOUT0 = 48 * MiB, WS_WOUT1 = 56 * MiB;
constexpr size_t WS_WGU = 64 * MiB;
constexpr size_t WS_WDN = 320 * MiB;
constexpr size_t WS_HB = 448 * MiB;
constexpr size_t WS_R1 = 576 * MiB;
constexpr size_t WS_R2 = 960 * MiB;
constexpr size_t WS_R3 = 1344 * MiB;
constexpr size_t WS_X1 = 1600 * MiB;
constexpr size_t WS_END = 1856 * MiB;
constexpr int CW_BAR = 4096;
constexpr int CW_NRM = 8192;

constexpr int RING_BYTES = 131072;
constexpr int MISC_OFF = RING_BYTES + 320;
constexpr int LDS_BYTES = 147456;

#define XB_TMO      128
#define XB_XCNT(j)  (256  + 64 * (j))
#define XB_XSUB(j)  (1280 + 64 * (j))
#define XB_XGEN(j)  (2304 + 64 * (j))
#define XB_TOP      3328
#define XB_TOPGEN   3392
#define XCD_BAR_WORDS 3456
#define XB_SPIN_CAP (1u << 18)

__device__ __forceinline__ unsigned xb_ld(unsigned* p)              { return __hip_atomic_load(p, __ATOMIC_RELAXED, __HIP_MEMORY_SCOPE_AGENT); }
__device__ __forceinline__ unsigned xb_add(unsigned* p, unsigned v) { return __hip_atomic_fetch_add(p, v, __ATOMIC_RELAXED, __HIP_MEMORY_SCOPE_AGENT); }
__device__ __forceinline__ unsigned xb_xcc_id() { return (unsigned)__builtin_amdgcn_s_getreg((3 << 11) | 20) & 0xFu; }
#define XB_SPIN(cond, bar) do { unsigned _sp = 0; while (cond) { __builtin_amdgcn_s_sleep(1); \
    if ((++_sp & 255u) == 0u) { if (xb_ld(&(bar)[XB_TMO])) break; if (_sp > XB_SPIN_CAP) { atomicAdd(&(bar)[XB_TMO], 1u); break; } } } } while (0)

struct XcdBarrier {
    unsigned* bar; unsigned x;
    volatile LAS unsigned* st;
};

__device__ __forceinline__ XcdBarrier xcd_barrier_post(unsigned* bar, volatile LAS unsigned* st) {
    XcdBarrier b; b.bar = bar; b.x = xb_xcc_id(); b.st = st;
    if (threadIdx.x == 0) (void)xb_add(&bar[XB_XCNT(b.x)], 1u);
    return b;
}
__device__ __forceinline__ void xcd_barrier_complete(unsigned* bar, unsigned x, unsigned& nloc, unsigned& nx) {
    const unsigned G = gridDim.x * gridDim.y * gridDim.z;
    unsigned sum, cnt, mine, sp = 0u;
    for (;;) {
        sum = 0u; cnt = 0u; mine = 0u;
#pragma unroll
        for (unsigned j = 0; j < 16; ++j) { const unsigned c = xb_ld(&bar[XB_XCNT(j)]); sum += c; cnt += (c > 0u) ? 1u : 0u; mine = (j == x) ? c : mine; }
        if (sum == G) break;
        __builtin_amdgcn_s_sleep(1);
        if ((++sp & 255u) == 0u) { if (xb_ld(&bar[XB_TMO])) break; if (sp > XB_SPIN_CAP) { atomicAdd(&bar[XB_TMO], 1u); break; } }
    }
    nloc = mine > 0u ? mine : 1u; nx = cnt > 0u ? cnt : 1u;
}

__device__ __forceinline__ void xcd_barrier(const XcdBarrier& b, const bool leader  ) {
    asm volatile("s_waitcnt vmcnt(0)" ::: "memory");
    __syncthreads();
    if (leader) {
        unsigned* bar = b.bar;
        __builtin_amdgcn_s_waitcnt(0);
        unsigned nloc = b.st[0], nx = b.st[1];
        if (nloc == 0u) { xcd_barrier_complete(bar, b.x, nloc, nx); b.st[0] = nloc; b.st[1] = nx; }
        const unsigned old = xb_add(&bar[XB_XSUB(b.x)], 1u);
        const unsigned gen = old / nloc;
        if (old + 1u == (gen + 1u) * nloc) {
            __builtin_amdgcn_fence(__ATOMIC_RELEASE, "agent");
            asm volatile("s_waitcnt vmcnt(0)" ::: "memory");
            const unsigned og = xb_add(&bar[XB_TOP], 1u);
            const unsigned tg = og / nx;
            if (og + 1u == (tg + 1u) * nx) xb_add(&bar[XB_TOPGEN], 1u);
            else XB_SPIN(xb_ld(&bar[XB_TOPGEN]) == tg, bar);
            __builtin_amdgcn_fence(__ATOMIC_ACQUIRE, "agent");
            xb_add(&bar[XB_XGEN(b.x)], 1u);
            asm volatile("s_waitcnt vmcnt(0)" ::: "memory");
        } else {
            XB_SPIN(xb_ld(&bar[XB_XGEN(b.x)]) == gen, bar);
            __builtin_amdgcn_fence(__ATOMIC_ACQUIRE, "agent");
            asm volatile("s_waitcnt vmcnt(0)" ::: "memory");
        }
    }
    __syncthreads();
}

namespace att {
constexpr int KVBLK = 64;
constexpr int SHM_V = KVBLK * 128 * 2, SHM_K = KVBLK * 128 * 2, SHM_ATTN = 3 * (SHM_V + SHM_K) + 8 * 64 * 4;
constexpr float THR = 8.f;
#define KSWZ(row, colB) ((row) * 256 + ((colB) ^ (((row) & 7) << 4)))
#define SBAR() __builtin_amdgcn_sched_barrier(0)
__device__ __forceinline__ int crow(int r, int hi) { return (r & 3) + 8 * (r >> 2) + 4 * hi; }
constexpr float THR2 = 8.f * 1.4426950408889634f;
__device__ __forceinline__ void partialSM(f32x16& p0, f32x16& p1, float& m_run, float& alpha) {
  float pmax = fmaxf(fmaxf(p0[0], p0[1]), p0[2]);
#pragma unroll
  for (int r = 3; r < 15; r += 2) pmax = fmaxf(fmaxf(pmax, p0[r]), p0[r + 1]);
  pmax = fmaxf(fmaxf(pmax, p0[15]), p1[0]);
#pragma unroll
  for (int r = 1; r < 15; r += 2) pmax = fmaxf(fmaxf(pmax, p1[r]), p1[r + 1]);
  pmax = fmaxf(pmax, p1[15]);
  { auto rr = __builtin_amdgcn_permlane32_swap(__float_as_uint(pmax), __float_as_uint(pmax), false, false);
    pmax = fmaxf(__uint_as_float(rr[0]), __uint_as_float(rr[1])); }
  if (__builtin_expect(__all(pmax <= THR2), 1)) { alpha = 1.f; }
  else { const float d = fmaxf(pmax, 0.f); alpha = __builtin_amdgcn_exp2f(-d); m_run += d;
#pragma unroll
    for (int r = 0; r < 16; ++r) { p0[r] -= d; p1[r] -= d; } }
#pragma unroll
  for (int r = 0; r < 16; ++r) p0[r] = __builtin_amdgcn_exp2f(p0[r]);
}
__device__ __forceinline__ void finishSM(f32x16& p0, f32x16& p1, float alpha, float& l_reg, bf16x8& pa0, bf16x8& pa1, bf16x8& pa2, bf16x8& pa3) {
#pragma unroll
  for (int r = 0; r < 16; ++r) p1[r] = __builtin_amdgcn_exp2f(p1[r]);
  float ps = 0;
#pragma unroll
  for (int r = 0; r < 16; ++r) ps += p0[r];
#pragma unroll
  for (int r = 0; r < 16; ++r) ps += p1[r];
  { auto rr = __builtin_amdgcn_permlane32_swap(__float_as_uint(ps), __float_as_uint(ps), false, false);
    ps = __uint_as_float(rr[0]) + __uint_as_float(rr[1]); }
  l_reg = l_reg * alpha + ps;
#define PK4(P, BASE, OUT) do { unsigned a0 = cvtpk(P[BASE + 0], P[BASE + 1]), a1 = cvtpk(P[BASE + 2], P[BASE + 3]);   \
    unsigned b0 = cvtpk(P[BASE + 4], P[BASE + 5]), b1 = cvtpk(P[BASE + 6], P[BASE + 7]);                              \
    auto r0 = __builtin_amdgcn_permlane32_swap(a0, b0, false, false); auto r1 = __builtin_amdgcn_permlane32_swap(a1, b1, false, false); \
    u32x4 w = {r0[0], r1[0], r0[1], r1[1]}; OUT = __builtin_bit_cast(bf16x8, w); } while (0)
  PK4(p0, 0, pa0); PK4(p0, 8, pa1); PK4(p1, 0, pa2); PK4(p1, 8, pa3);
#undef PK4
}
template <bool BANDED>
__device__ __forceinline__ void qkt(f32x16& p0, f32x16& p1, const LAS char* Ks, const bf16x8* qr, int r32, int hi, float base, float nsl2, float radius, float m_run, int side) {
  if (!BANDED && side != 0) {
    const float sa = nsl2 * (float)side, t = fmaf(sa, base, -m_run), na = -sa;
#pragma unroll
    for (int r = 0; r < 16; ++r) { const float c = (float)((r & 3) + 8 * (r >> 2)); p0[r] = fmaf(na, c, t); p1[r] = fmaf(na, c + 32.f, t); }
  } else {
#pragma unroll
    for (int r = 0; r < 16; ++r) { const float c = (float)((r & 3) + 8 * (r >> 2));
      const float a0 = __builtin_fabsf(base - c), a1 = __builtin_fabsf(base - (c + 32.f));
      float v0 = fmaf(a0, nsl2, -m_run), v1 = fmaf(a1, nsl2, -m_run);
      if (BANDED) { v0 = a0 > radius ? -INFINITY : v0; v1 = a1 > radius ? -INFINITY : v1; }
      p0[r] = v0; p1[r] = v1; }
  }
#pragma unroll
  for (int d0 = 0; d0 < 8; ++d0) { const int cb = (d0 * 16 + hi * 8) * 2;
    const bf16x8 b0 = *(const LAS bf16x8*)(Ks + KSWZ(r32, cb));
    const bf16x8 b1 = *(const LAS bf16x8*)(Ks + KSWZ(32 + r32, cb));
    p0 = __builtin_amdgcn_mfma_f32_32x32x16_bf16(b0, qr[d0], p0, 0, 0, 0);
    p1 = __builtin_amdgcn_mfma_f32_32x32x16_bf16(b1, qr[d0], p1, 0, 0, 0); }
}
__device__ __forceinline__ int v_st(int k, int c) { const int kk = (k & ~0xC) | ((k & 4) << 1) | ((k & 8) >> 1); return ((kk >> 3) * 4 + (c >> 5)) * 512 + ((kk & 7) * 32 + (c & 31)) * 2; }
__device__ __forceinline__ int v_rd_base(int lane) { return ((lane & 3) << 3) | (((lane >> 2) & 3) << 6) | (((lane >> 4) & 1) << 5) | (((lane >> 5) & 1) << 8); }
constexpr int v_rd_off(int d0, int ks, int half) { return d0 * 512 + ks * 4096 + half * 2048; }
template <int OFF> __device__ __forceinline__ s16x4 tr_read(int vb) {
  s16x4 r; asm volatile("ds_read_b64_tr_b16 %0, %1 offset:%2" : "=&v"(r) : "v"(vb), "i"(OFF) : "memory"); return r;
}
template <int D0> __device__ __forceinline__ void pv_one(f32x16& od, int vb, bf16x8 pa0, bf16x8 pa1, bf16x8 pa2, bf16x8 pa3) {
  const s16x4 l0 = tr_read<v_rd_off(D0, 0, 0)>(vb), h0 = tr_read<v_rd_off(D0, 0, 1)>(vb), l1 = tr_read<v_rd_off(D0, 1, 0)>(vb), h1 = tr_read<v_rd_off(D0, 1, 1)>(vb);
  const s16x4 l2 = tr_read<v_rd_off(D0, 2, 0)>(vb), h2 = tr_read<v_rd_off(D0, 2, 1)>(vb), l3 = tr_read<v_rd_off(D0, 3, 0)>(vb), h3 = tr_read<v_rd_off(D0, 3, 1)>(vb);
  asm volatile("s_waitcnt lgkmcnt(0)" ::: "memory"); SBAR();
#define PK(L, H) (bf16x8){L[0], L[1], L[2], L[3], H[0], H[1], H[2], H[3]}
  od = __builtin_amdgcn_mfma_f32_32x32x16_bf16(pa0, PK(l0, h0), od, 0, 0, 0);
  od = __builtin_amdgcn_mfma_f32_32x32x16_bf16(pa1, PK(l1, h1), od, 0, 0, 0);
  od = __builtin_amdgcn_mfma_f32_32x32x16_bf16(pa2, PK(l2, h2), od, 0, 0, 0);
  od = __builtin_amdgcn_mfma_f32_32x32x16_bf16(pa3, PK(l3, h3), od, 0, 0, 0);
#undef PK
}
__device__ __forceinline__ void pv_d0(f32x16* o, int vb, bf16x8 pa0, bf16x8 pa1, bf16x8 pa2, bf16x8 pa3) {
  pv_one<0>(o[0], vb, pa0, pa1, pa2, pa3); pv_one<1>(o[1], vb, pa0, pa1, pa2, pa3); pv_one<2>(o[2], vb, pa0, pa1, pa2, pa3); pv_one<3>(o[3], vb, pa0, pa1, pa2, pa3);
}

template <bool BANDED>
__device__ __forceinline__ void attn_unit(const bf16_t* __restrict__ Qb, int ldq, const bf16_t* __restrict__ Kt, const bf16_t* __restrict__ Vt, int ldk,
                                          bf16_t* __restrict__ Ob, int ldo, float* __restrict__ Lb, int ldl,
                                          int qrel, int NT, float nsl2, float radius, float sink2, LAS char* lds, const int wave0, const bool o8 = false) {
  int tid = wave0 * 64 + ({ int l_; asm volatile("v_mbcnt_lo_u32_b32 %0, -1, 0\n\tv_mbcnt_hi_u32_b32 %0, -1, %0" : "=v"(l_)); l_; });
  const int wid = tid >> 6, lane = tid & 63, r32 = lane & 31, hi = lane >> 5;
  const int wu = __builtin_amdgcn_readfirstlane(wid);
  LAS float* ws = (LAS float*)(lds + 3 * 32768) + wid * 64; LAS float* li_l = ws; LAS float* al_l = ws + 32;
  __syncthreads();
  const __amdgpu_buffer_rsrc_t krs = __builtin_amdgcn_make_buffer_rsrc((void*)Kt, 0, 0x7FFFFFFF, 0x00020000), vrs = __builtin_amdgcn_make_buffer_rsrc((void*)Vt, 0, 0x7FFFFFFF, 0x00020000);
  int koffD[2], voffD[2];
#pragma unroll
  for (int i = 0; i < 2; ++i) { const int row = (i * 8 + wid) * 4 + (lane >> 4), cp = lane & 15; koffD[i] = (row * ldk) * 2 + ((cp ^ (row & 7)) << 4);
    const int s_ = (i * 8 + wid) * 2 + (lane >> 5), kk = (s_ >> 2) * 8 + ((lane & 31) >> 2), c = (s_ & 3) * 32 + (lane & 3) * 8, k = (kk & ~0xC) | ((kk & 4) << 1) | ((kk & 8) >> 1);
    voffD[i] = (k * ldk + c) * 2; }
  const int tstep = 128 * ldk;
#define DISSUE(j) do { const int o_ = (j) * tstep; LAS char* sb_ = lds + ((j) % 3) * 32768 + wu * 1024; \
    __builtin_amdgcn_raw_ptr_buffer_load_lds(vrs, (LAS void*)(sb_), 16, voffD[0], o_, 0, 0); __builtin_amdgcn_raw_ptr_buffer_load_lds(vrs, (LAS void*)(sb_ + 8192), 16, voffD[1], o_, 0, 0); \
    __builtin_amdgcn_raw_ptr_buffer_load_lds(krs, (LAS void*)(sb_ + 16384), 16, koffD[0], o_, 0, 0); __builtin_amdgcn_raw_ptr_buffer_load_lds(krs, (LAS void*)(sb_ + 16384 + 8192), 16, koffD[1], o_, 0, 0); } while (0)
#define BAR() asm volatile("s_waitcnt lgkmcnt(0)\n\ts_barrier" ::: "memory")
#define WAITBAR(more) do { if (more) asm volatile("s_waitcnt vmcnt(4) lgkmcnt(0)\n\ts_barrier" ::: "memory"); else asm volatile("s_waitcnt vmcnt(0) lgkmcnt(0)\n\ts_barrier" ::: "memory"); } while (0)
  DISSUE(0); DISSUE(1);
  float m_reg = 0.f, l_reg = 0; f32x16 o[4] = {}; bf16x8 qr[8];
  { const unsigned qoff = (unsigned)((wid * 32 + r32) * ldq + hi * 8) * 2u;
#pragma unroll
    for (int d0 = 0; d0 < 8; ++d0) qr[d0] = *(const bf16x8*)((const char*)Qb + (qoff + d0 * 32)); }
  const int vb0 = (int)(unsigned)(uintptr_t)lds + v_rd_base(lane);
  const float qb_f = (float)(qrel + wid * 32 + r32 - 4 * hi);
#define RESC(a) do { if (__any((a) < 1.f)) { if (hi == 0) al_l[r32] = (a); asm volatile("s_waitcnt lgkmcnt(0)" ::: "memory"); \
    _Pragma("unroll") for (int d = 0; d < 4; ++d) _Pragma("unroll") for (int r = 0; r < 16; ++r) o[d][r] *= al_l[crow(r, hi)]; } } while (0)
#define SLOT(j) ({ int so_ = ((j) % 3) * 32768; asm volatile("" : "+s"(so_)); so_; })
#define SIDE(j) ((64 * (j) + 63 <= qw_) ? 1 : ((64 * (j) >= qw_ + 31) ? -1 : 0))
#define QKT(P0, P1, j) qkt<BANDED>(P0, P1, lds + SLOT(j) + 16384, qr, r32, hi, qb_f - (float)(64 * (j)), nsl2, radius, m_reg, SIDE(j))
#define PV(j) pv_d0(o, vb0 + SLOT(j), pa0, pa1, pa2, pa3)
  f32x16 pA0, pA1, pB0, pB1; float alA, alB; bf16x8 pa0, pa1, pa2, pa3;
  const int qw_ = __builtin_amdgcn_readfirstlane(qrel + 32 * wid), ri_ = (int)radius;
#define NEED(j) (!BANDED || ((64 * (j) + 63 >= qw_ - ri_) && (64 * (j) <= qw_ + 31 + ri_)))
#define QKTN(P0, P1, j, need) do { if (need) QKT(P0, P1, j); } while (0)
#define PSM(P0, P1, AL, need) do { if (need) partialSM(P0, P1, m_reg, AL); else AL = 1.f; } while (0)
#define FSM(P0, P1, AL, need) do { if (need) finishSM(P0, P1, AL, l_reg, pa0, pa1, pa2, pa3); } while (0)
  asm volatile("s_waitcnt vmcnt(0) lgkmcnt(0)\n\ts_barrier" ::: "memory");
  { const bool n0 = NEED(0); QKTN(pA0, pA1, 0, n0); PSM(pA0, pA1, alA, n0); }
  if (2 < NT) DISSUE(2);
  for (int j = 1; j + 1 < NT; j += 2) {
    const bool nP = NEED(j - 1), nC = NEED(j), nN = NEED(j + 1);
    SBAR(); QKTN(pB0, pB1, j, nC);
    FSM(pA0, pA1, alA, nP); SBAR();
    if (nP) PV(j - 1); PSM(pB0, pB1, alB, nC);
    BAR(); if (j + 2 < NT) DISSUE(j + 2);
    if (nC) RESC(alB); WAITBAR(j + 2 < NT);
    SBAR(); QKTN(pA0, pA1, j + 1, nN);
    FSM(pB0, pB1, alB, nC); SBAR();
    if (nC) PV(j); PSM(pA0, pA1, alA, nN);
    BAR(); if (j + 3 < NT) DISSUE(j + 3);
    if (nN) RESC(alA); WAITBAR(j + 3 < NT);
  }
  { const bool nP = NEED(NT - 2), nC = NEED(NT - 1);
    SBAR(); QKTN(pB0, pB1, NT - 1, nC);
    FSM(pA0, pA1, alA, nP); SBAR();
    if (nP) PV(NT - 2); PSM(pB0, pB1, alB, nC);
    if (nC) { RESC(alB);
      finishSM(pB0, pB1, alB, l_reg, pa0, pa1, pa2, pa3); SBAR();
      PV(NT - 1); } }
#undef PSM
#undef FSM
#undef QKTN
#undef DISSUE
#undef BAR
#undef WAITBAR
#undef PV
#undef SLOT
#undef SIDE
  { const float mf = fmaxf(m_reg, sink2); const float a = __builtin_amdgcn_exp2f(m_reg - mf); const float lnew = l_reg * a + __builtin_amdgcn_exp2f(sink2 - mf);
    if (hi == 0) li_l[r32] = a / lnew;
    if (Lb != nullptr && hi == 0) Lb[(wid * 32 + r32) * ldl] = (m_reg + __log2f(l_reg)) * 0.69314718055994531f; }
  asm volatile("s_waitcnt lgkmcnt(0)" ::: "memory");
  float rli[16];
#pragma unroll
  for (int r = 0; r < 16; ++r) rli[r] = li_l[crow(r, hi)];
  __syncthreads();
  if (o8) { LAS char* st = lds + wid * 8448;
#pragma unroll
    for (int r = 0; r < 16; ++r) { const int orow = crow(r, hi); const float sc = rli[r] * YATT_SCALE;
#pragma unroll
      for (int d0 = 0; d0 < 4; ++d0) { const float x = __builtin_fminf(__builtin_fmaxf(o[d0][r] * sc, -448.f), 448.f);
        *(LAS unsigned char*)(st + orow * 136 + d0 * 32 + r32) = (unsigned char)(__builtin_amdgcn_cvt_pk_fp8_f32(x, 0.f, 0, false) & 0xff); } }
    asm volatile("s_waitcnt lgkmcnt(0)" ::: "memory");
    const int rr = lane >> 3, ch = lane & 7;
#pragma unroll
    for (int t = 0; t < 4; ++t) { const int row = 8 * t + rr; const u32x2 lo = *(const LAS u32x2*)(st + row * 136 + ch * 16), hi2 = *(const LAS u32x2*)(st + row * 136 + ch * 16 + 8);
      *(u32x4*)((char*)Ob + ((size_t)(unsigned)((wid * 32 + row) * ldo)) * 2 + ch * 16) = (u32x4){lo.x, lo.y, hi2.x, hi2.y}; } }
  else { LAS char* st = lds + wid * 8448;
#pragma unroll
    for (int r = 0; r < 16; ++r) { const int orow = crow(r, hi);
#pragma unroll
      for (int d0 = 0; d0 < 4; ++d0) *(LAS unsigned short*)(st + orow * 264 + (d0 * 32 + r32) * 2) = (unsigned short)(cvtpk(o[d0][r] * rli[r], 0.f) & 0xffffu); }
    asm volatile("s_waitcnt lgkmcnt(0)" ::: "memory");
    const int rr = lane >> 4, ch = lane & 15;
#pragma unroll
    for (int t = 0; t < 8; ++t) { const int row = 4 * t + rr; const u32x2 lo = *(const LAS u32x2*)(st + row * 264 + ch * 16), hi2 = *(const LAS u32x2*)(st + row * 264 + ch * 16 + 8);
      *(u32x4*)((char*)Ob + ((size_t)(unsigned)((wid * 32 + row) * ldo + ch * 8)) * 2) = (u32x4){lo.x, lo.y, hi2.x, hi2.y}; } }
#undef RESC
#undef QKT
#undef NEED
}

__device__ __forceinline__ void softmax_tile(f32x16& p0, f32x16& p1, float& m_run, float& alpha, float& l_reg, bf16x8& pa0, bf16x8& pa1, bf16x8& pa2, bf16x8& pa3) {
  partialSM(p0, p1, m_run, alpha); finishSM(p0, p1, alpha, l_reg, pa0, pa1, pa2, pa3);
}
__device__ __forceinline__ void attn_unit256(const bf16_t* __restrict__ Qb, int ldq, const bf16_t* __restrict__ Kt, const bf16_t* __restrict__ Vt, int ldk,
                                             bf16_t* __restrict__ Ob, int ldo, int qrel, int NT, float nsl2, LAS char* lds, const int wave0) {
  int tid = wave0 * 64 + ({ int l_; asm volatile("v_mbcnt_lo_u32_b32 %0, -1, 0\n\tv_mbcnt_hi_u32_b32 %0, -1, %0" : "=v"(l_)); l_; });
  const int wid = tid >> 6, lane = tid & 63, r32 = lane & 31, hi = lane >> 5;
  const int wu = __builtin_amdgcn_readfirstlane(wid);
  constexpr int KS = 0, VS = 32768, WSO = 98304;
  LAS float* ws = (LAS float*)(lds + WSO) + wid * 64; LAS float* li_l = ws; LAS float* al_l = ws + 32;
  __syncthreads();
  const __amdgpu_buffer_rsrc_t krs = __builtin_amdgcn_make_buffer_rsrc((void*)Kt, 0, 0x7FFFFFFF, 0x00020000), vrs = __builtin_amdgcn_make_buffer_rsrc((void*)Vt, 0, 0x7FFFFFFF, 0x00020000);
  int koffD[2], voffD[2];
#pragma unroll
  for (int i = 0; i < 2; ++i) { const int row = (i * 8 + wid) * 4 + (lane >> 4), cp = lane & 15; koffD[i] = (row * ldk) * 2 + ((cp ^ (row & 7)) << 4);
    const int s_ = (i * 8 + wid) * 2 + (lane >> 5), kk = (s_ >> 2) * 8 + ((lane & 31) >> 2), c = (s_ & 3) * 32 + (lane & 3) * 8, k = (kk & ~0xC) | ((kk & 4) << 1) | ((kk & 8) >> 1);
    voffD[i] = (k * ldk + c) * 2; }
  const int tstep = 128 * ldk;
#define ISSUEK(j) do { const int o_ = (j) * tstep; LAS char* sb_ = lds + KS + ((j) & 1) * 16384 + wu * 1024; \
    __builtin_amdgcn_raw_ptr_buffer_load_lds(krs, (LAS void*)(sb_), 16, koffD[0], o_, 0, 0); __builtin_amdgcn_raw_ptr_buffer_load_lds(krs, (LAS void*)(sb_ + 8192), 16, koffD[1], o_, 0, 0); } while (0)
#define ISSUEV(j) do { const int o_ = (j) * tstep; LAS char* sb_ = lds + VS + ((j) & 1) * 32768 + wu * 1024; \
    __builtin_amdgcn_raw_ptr_buffer_load_lds(vrs, (LAS void*)(sb_), 16, voffD[0], o_, 0, 0); __builtin_amdgcn_raw_ptr_buffer_load_lds(vrs, (LAS void*)(sb_ + 8192), 16, voffD[1], o_, 0, 0); \
    __builtin_amdgcn_raw_ptr_buffer_load_lds(vrs, (LAS void*)(sb_ + 16384), 16, voffD[0] + 256, o_, 0, 0); __builtin_amdgcn_raw_ptr_buffer_load_lds(vrs, (LAS void*)(sb_ + 16384 + 8192), 16, voffD[1] + 256, o_, 0, 0); } while (0)
  ISSUEK(0); ISSUEV(0);
  float m_reg = 0.f, l_reg = 0.f, al = 1.f; f32x16 o[8] = {}; bf16x8 qr[8];
  { const unsigned qoff = (unsigned)((wid * 32 + r32) * ldq + hi * 8) * 2u;
#pragma unroll
    for (int d0 = 0; d0 < 8; ++d0) qr[d0] = *(const bf16x8*)((const char*)Qb + (qoff + d0 * 32)); }
  const int vb0 = (int)(unsigned)(uintptr_t)lds + VS + v_rd_base(lane);
  const float qb_f = (float)(qrel + wid * 32 + r32 - 4 * hi);
  const int qw_ = __builtin_amdgcn_readfirstlane(qrel + 32 * wid);
  f32x16 p0, p1; bf16x8 pa0, pa1, pa2, pa3;
#define RESC8(a) do { if (__any((a) < 1.f)) { if (hi == 0) al_l[r32] = (a); asm volatile("s_waitcnt lgkmcnt(0)" ::: "memory"); \
    _Pragma("unroll") for (int d = 0; d < 8; ++d) _Pragma("unroll") for (int r = 0; r < 16; ++r) o[d][r] *= al_l[crow(r, hi)]; } } while (0)
#define OPQ(x) ({ int so_ = __builtin_amdgcn_readfirstlane(x); asm volatile("" : "+s"(so_)); so_; })
#define QKSM(j) do { qkt<false>(p0, p1, lds + KS + OPQ(((j) & 1) * 16384), qr, r32, hi, qb_f - (float)(64 * (j)), nsl2, 0.f, m_reg, ((64 * (j) + 63 <= qw_) ? 1 : ((64 * (j) >= qw_ + 31) ? -1 : 0))); \
    softmax_tile(p0, p1, m_reg, al, l_reg, pa0, pa1, pa2, pa3); } while (0)
#define PV8(j) do { const int vb_ = vb0 + OPQ(((j) & 1) * 32768); RESC8(al); pv_d0(o, vb_, pa0, pa1, pa2, pa3); pv_d0(o + 4, vb_ + 16384, pa0, pa1, pa2, pa3); } while (0)
  asm volatile("s_waitcnt vmcnt(0) lgkmcnt(0)\n\ts_barrier" ::: "memory");
  for (int j = 0; j < NT; ++j) {
    if (j > 0) asm volatile("s_waitcnt vmcnt(0) lgkmcnt(0)\n\ts_barrier" ::: "memory");
    if (j + 1 < NT) { ISSUEK(j + 1); ISSUEV(j + 1); }
    QKSM(j); PV8(j);
  }
  if (hi == 0) li_l[r32] = 1.0f / l_reg;
  asm volatile("s_waitcnt lgkmcnt(0)" ::: "memory");
  float rli[16];
#pragma unroll
  for (int r = 0; r < 16; ++r) rli[r] = li_l[crow(r, hi)];
#pragma unroll
  for (int half = 0; half < 2; ++half) {
    __syncthreads();
    LAS char* st = lds + wid * 8448;
#pragma unroll
    for (int r = 0; r < 16; ++r) { const int orow = crow(r, hi);
#pragma unroll
      for (int d0 = 0; d0 < 4; ++d0) *(LAS unsigned short*)(st + orow * 264 + (d0 * 32 + r32) * 2) = (unsigned short)(cvtpk(o[half * 4 + d0][r] * rli[r], 0.f) & 0xffffu); }
    asm volatile("s_waitcnt lgkmcnt(0)" ::: "memory");
    const int rr = lane >> 4, ch = lane & 15;
#pragma unroll
    for (int t = 0; t < 8; ++t) { const int row = 4 * t + rr; const u32x2 lo = *(const LAS u32x2*)(st + row * 264 + ch * 16), hi2 = *(const LAS u32x2*)(st + row * 264 + ch * 16 + 8);
      *(u32x4*)((char*)Ob + ((size_t)(unsigned)((wid * 32 + row) * ldo + half * 128 + ch * 8)) * 2) = (u32x4){lo.x, lo.y, hi2.x, hi2.y}; }
  }
#undef ISSUEK
#undef ISSUEV
#undef RESC8
#undef OPQ
#undef QKSM
#undef PV8
}
}

struct Args { const float* in[17]; float* out; unsigned char* ws; int ph_lo, ph_hi; };
enum { IN_X = 0, IN_C, IN_ADAW, IN_ADAB, IN_LNG, IN_LNB, IN_ABWIN, IN_ABWOUT, IN_DLAM, IN_SUBLN, IN_CWIN, IN_CWOUT, IN_CSINK, IN_ROUTER, IN_WGATE, IN_WUP, IN_WDOWN };

__device__ __forceinline__ void transpose_item(const float* __restrict__ W, int ldn, int K, int k0, int n0, bf16_t* __restrict__ dst, int drow0, float wscale, LAS float* scr, int lane) {
    f32x4 v[8];
#pragma unroll
    for (int i = 0; i < 8; ++i) v[i] = *(const f32x4*)(W + (size_t)(k0 + 8 * i + (lane >> 3)) * ldn + n0 + 4 * (lane & 7));
#pragma unroll
    for (int i = 0; i < 8; ++i) { LAS float* d = scr + (8 * i + (lane >> 3)) * 33 + 4 * (lane & 7); d[0] = v[i][0] * wscale; d[1] = v[i][1] * wscale; d[2] = v[i][2] * wscale; d[3] = v[i][3] * wscale; }
    LDS_WAIT(); asm volatile("" ::: "memory");
    const int c = lane & 7;
#pragma unroll
    for (int j = 0; j < 4; ++j) { const int n = (lane >> 3) + 8 * j; const LAS float* s = scr + (8 * c) * 33 + n;
        u32x4 o; o.x = cvtpk(s[0 * 33], s[1 * 33]); o.y = cvtpk(s[2 * 33], s[3 * 33]); o.z = cvtpk(s[4 * 33], s[5 * 33]); o.w = cvtpk(s[6 * 33], s[7 * 33]);
        *(u32x4*)(dst + (size_t)(drow0 + n) * K + k0 + 8 * c) = o; }
    LDS_WAIT(); asm volatile("" ::: "memory");
}
__device__ __forceinline__ void transpose_item_f8(const float* __restrict__ W, int ldn, int K, int k0, int n0, unsigned char* __restrict__ dst, int drow0, float wscale, LAS float* scr, int lane) {
    f32x4 v[8];
#pragma unroll
    for (int i = 0; i < 8; ++i) v[i] = __builtin_nontemporal_load((const f32x4*)(W + (size_t)(k0 + 8 * i + (lane >> 3)) * ldn + n0 + 4 * (lane & 7)));
#pragma unroll
    for (int i = 0; i < 8; ++i) { LAS float* d = scr + (8 * i + (lane >> 3)) * 33 + 4 * (lane & 7); d[0] = v[i][0] * wscale; d[1] = v[i][1] * wscale; d[2] = v[i][2] * wscale; d[3] = v[i][3] * wscale; }
    LDS_WAIT(); asm volatile("" ::: "memory");
    const int c = lane & 3;
#pragma unroll
    for (int j = 0; j < 2; ++j) { const int n = (lane >> 2) + 16 * j; const LAS float* s = scr + (16 * c) * 33 + n;
        int w[4];
#pragma unroll
        for (int q = 0; q < 4; ++q) { w[q] = __builtin_amdgcn_cvt_pk_fp8_f32(s[(4 * q + 0) * 33], s[(4 * q + 1) * 33], 0, false); w[q] = __builtin_amdgcn_cvt_pk_fp8_f32(s[(4 * q + 2) * 33], s[(4 * q + 3) * 33], w[q], true); }
        __builtin_nontemporal_store((u32x4){(unsigned)w[0], (unsigned)w[1], (unsigned)w[2], (unsigned)w[3]}, (u32x4*)(dst + (size_t)(drow0 + n) * K + k0 + 16 * c)); }
    LDS_WAIT(); asm volatile("" ::: "memory");
}
constexpr float QSCALE = SCALE * 1.4426950408889634f;
__device__ __forceinline__ void conv_plain_item(const float* W, int K, int N, bf16_t* dst, int item, int qmode, LAS float* scr, int lane) {
    const int nblk = N / 32, kb = item / nblk, nb = item % nblk, n0 = 32 * nb;
    const bool isq = qmode == 1 ? (n0 < 1024 || (n0 >= 3072 && n0 < 4096)) : (qmode == 2 ? n0 < 2048 : false);
    transpose_item(W, N, K, 64 * kb, n0, dst, n0, isq ? QSCALE : 1.0f, scr, lane);
}
__device__ __forceinline__ void conv_ffn_item(const Args& a, int l, int item, LAS float* scr, int lane) {
    const int m = item >> 11, r = item & 2047, kind = m >> 4, e = m & 15, kb = r >> 6, nb = r & 63, n0 = 32 * nb;
    const size_t eoff = ((size_t)l * NE + e) * (size_t)DM * EH;
    if (kind == 2) { transpose_item_f8(a.in[IN_WDOWN] + eoff, DM, EH, 64 * kb, n0, (unsigned char*)(a.ws + WS_WDN) + (size_t)e * DM * EH, n0, WDN_SCALE, scr, lane); }
    else { const float* W = (kind == 0 ? a.in[IN_WGATE] : a.in[IN_WUP]) + eoff;
           const int drow = (n0 >> 7) * 256 + (n0 & 127) + (kind == 1 ? 128 : 0);
           transpose_item_f8(W, EH, DM, 64 * kb, n0, (unsigned char*)(a.ws + WS_WGU) + (size_t)e * 4096 * DM, drow, WGU_SCALE, scr, lane); }
}

__device__ __forceinline__ void phase_prologue(const Args& a, LAS unsigned char* lds, int tid, int lane, int wave, int vcu, int G, int bx) {
    float* MOD = (float*)(a.ws + WS_MOD);
    for (int it = bx; it < 192; it += G) {
        const int l = it / 96, n0 = (it % 96) * 128;
        LAS float* cs = (LAS float*)lds;
        for (int i = tid; i < NB * DM; i += 512) { const int b = i >> 11, k = i & 2047; const float c = a.in[IN_C][i]; cs[k * 8 + b] = c / (1.f + expf(-c)); }
        __syncthreads();
        const int hl = lane >> 5, l32 = lane & 31;
        const float* W = a.in[IN_ADAW] + (size_t)l * DM * 6 * DM + n0 + 4 * l32;
        f32x4 acc[8];
#pragma unroll
        for (int b = 0; b < 8; ++b) acc[b] = (f32x4){0.f, 0.f, 0.f, 0.f};
        const int kbeg = wave * 256;
#pragma unroll 8
        for (int kk = 0; kk < 128; ++kk) { const int k = kbeg + 2 * kk + hl; const f32x4 w = *(const f32x4*)(W + (size_t)k * (6 * DM));
            const f32x4 c0 = *(const LAS f32x4*)(cs + k * 8), c1 = *(const LAS f32x4*)(cs + k * 8 + 4);
            acc[0] += w * c0[0]; acc[1] += w * c0[1]; acc[2] += w * c0[2]; acc[3] += w * c0[3]; acc[4] += w * c1[0]; acc[5] += w * c1[1]; acc[6] += w * c1[2]; acc[7] += w * c1[3]; }
        LAS float* part = (LAS float*)(lds + 65536);
#pragma unroll
        for (int b = 0; b < 8; ++b) { f32x4 s;
#pragma unroll
            for (int e = 0; e < 4; ++e) s[e] = swap32_add(acc[b][e], acc[b][e]);
            if (hl == 0) *(LAS f32x4*)(part + (wave * 8 + b) * 128 + 4 * l32) = s; }
        __syncthreads();
        for (int o = tid; o < 1024; o += 512) { const int b = o >> 7, col = o & 127; float s = 0.f;
#pragma unroll
            for (int w = 0; w < 8; ++w) s += part[(w * 8 + b) * 128 + col];
            MOD[(size_t)(l * 8 + b) * (6 * DM) + n0 + col] = s + a.in[IN_ADAB][l * 6 * DM + n0 + col]; }
        __syncthreads();
    }
    LAS float* scr = (LAS float*)(lds + wave * 16384);
    const int gw = vcu * 8 + wave, NGW = G * 8;
    constexpr int I_IN0 = (DM / 64) * (AB_IN / 32), I_OUT = (DM / 64) * (DM / 32), I_IN1 = (DM / 64) * (C_IN / 32), I_FFN = 48 * 2048;
    constexpr int NITEMS = I_IN0 + I_OUT + I_IN1 + I_OUT; (void)I_FFN;
    for (int it = gw; it < NITEMS; it += NGW) {
        int r = it;
        if (r < I_IN0) { const int n0 = 32 * (r % (AB_IN / 32));
            if (n0 < 3072) conv_plain_item(a.in[IN_ABWIN], DM, AB_IN, (bf16_t*)(a.ws + WS_WIN0), r, 1, scr, lane);
            else transpose_item_f8(a.in[IN_ABWIN], AB_IN, DM, 64 * (r / (AB_IN / 32)), n0, (unsigned char*)(a.ws + WS_WIN0) + (size_t)3072 * DM * 2, n0 - 3072, (n0 < 4096 ? QSCALE : 1.0f) * WIN1_SCALE, scr, lane);
            continue; } r -= I_IN0;
        if (r < I_OUT) { conv_plain_item(a.in[IN_ABWOUT], DM, DM, (bf16_t*)(a.ws + WS_WOUT0), r, 0, scr, lane); continue; } r -= I_OUT;
        if (r < I_IN1) { const int kb = r / (C_IN / 32), n0 = 32 * (r % (C_IN / 32)); transpose_item_f8(a.in[IN_CWIN], C_IN, DM, 64 * kb, n0, (unsigned char*)(a.ws + WS_WIN1), n0, (n0 < 2048 ? QSCALE : 1.0f) * WIN1_SCALE, scr, lane); continue; } r -= I_IN1;
        if (r < I_OUT) { const int kb = r / (DM / 32), nb = r % (DM / 32); transpose_item_f8(a.in[IN_CWOUT], DM, DM, 64 * kb, 32 * nb, (unsigned char*)(a.ws + WS_WOUT1), 32 * nb, WOUT_SCALE, scr, lane); continue; } r -= I_OUT;
    }
}

__device__ __forceinline__ void phase_modulate0(const Args& a, int lane, int wave, int vcu, int G) {
    const float* MOD = (const float*)(a.ws + WS_MOD); bf16_t* HB = (bf16_t*)(a.ws + WS_HB); unsigned char* H8 = (unsigned char*)(a.ws + WS_R2);
    const int gw = vcu * 8 + wave, NGW = G * 8;
#pragma unroll 1
    for (int row = gw; row < T; row += 2 * NGW) {
        f32x4 x[2][8];
#pragma unroll
        for (int p = 0; p < 2; ++p)
#pragma unroll
            for (int j = 0; j < 4; ++j)
#pragma unroll
                for (int q = 0; q < 2; ++q) x[p][2 * j + q] = *(const f32x4*)(a.in[IN_X] + (size_t)(row + p * NGW) * DM + 8 * lane + 512 * j + 4 * q);
#pragma unroll
        for (int p = 0; p < 2; ++p) { const int r = row + p * NGW; const float* mb = MOD + (size_t)(r >> 12) * (6 * DM);
#pragma unroll
            for (int j = 0; j < 4; ++j) { const int col = 8 * lane + 512 * j;
                const f32x4 s0 = *(const f32x4*)(mb + DM + col) + 1.0f, s1 = *(const f32x4*)(mb + DM + col + 4) + 1.0f, t0 = *(const f32x4*)(mb + col), t1 = *(const f32x4*)(mb + col + 4);
                const f32x4 h0 = x[p][2 * j] * s0 + t0, h1 = x[p][2 * j + 1] * s1 + t1;
                u32x4 w; w.x = cvtpk(h0[0], h0[1]); w.y = cvtpk(h0[2], h0[3]); w.z = cvtpk(h1[0], h1[1]); w.w = cvtpk(h1[2], h1[3]);
                *(u32x4*)(HB + (size_t)r * DM + col) = w;
                const f32x4 c0 = __builtin_elementwise_min(__builtin_elementwise_max(h0 * HIN1_SCALE, (f32x4){-448.f, -448.f, -448.f, -448.f}), (f32x4){448.f, 448.f, 448.f, 448.f}), c1 = __builtin_elementwise_min(__builtin_elementwise_max(h1 * HIN1_SCALE, (f32x4){-448.f, -448.f, -448.f, -448.f}), (f32x4){448.f, 448.f, 448.f, 448.f});
                unsigned w0, w1; asm volatile("v_cvt_pk_fp8_f32 %0, %1, %2" : "=v"(w0) : "v"(c0[0]), "v"(c0[1])); asm volatile("v_cvt_pk_fp8_f32 %0, %1, %2 op_sel:[0,0,1]" : "+v"(w0) : "v"(c0[2]), "v"(c0[3]));
                asm volatile("v_cvt_pk_fp8_f32 %0, %1, %2" : "=v"(w1) : "v"(c1[0]), "v"(c1[1])); asm volatile("v_cvt_pk_fp8_f32 %0, %1, %2 op_sel:[0,0,1]" : "+v"(w1) : "v"(c1[2]), "v"(c1[3]));
                *(u32x2*)(H8 + (size_t)r * DM + col) = (u32x2){w0, w1}; } }
    }
}

__device__ __forceinline__ void norms_item(const Args& a, int it, const int wave0) {
    const bf16_t* P = (const bf16_t*)(a.ws + WS_R1); unsigned* NRM = (unsigned*)(a.ws + WS_CTL) + CW_NRM;
    const int lane = ({ int l_; asm volatile("v_mbcnt_lo_u32_b32 %0, -1, 0\n\tv_mbcnt_hi_u32_b32 %0, -1, %0" : "=v"(l_)); l_; });
    const int wid = wave0, r32 = lane & 31, hi = lane >> 5;
    {
        const int kind = it & 1, rest = it >> 1, combo = rest >> 4, qb = rest & 15, b = combo >> 3, h = (combo >> 1) & 3, map = combo & 1;
        const bf16_t* base = P + (size_t)(b * SEQ + qb * 256 + wid * 32 + r32) * AB_IN + (kind ? 1024 : 0) + (h * 2 + map) * 128 + hi * 8;
        float ss = 0.f, dot = 0.f;
#pragma unroll
        for (int d0 = 0; d0 < 8; ++d0) { const u32x4 v = *(const u32x4*)(base + d0 * 16);
            ss += bf_lo(v.x) * bf_lo(v.x) + bf_hi(v.x) * bf_hi(v.x) + bf_lo(v.y) * bf_lo(v.y) + bf_hi(v.y) * bf_hi(v.y) + bf_lo(v.z) * bf_lo(v.z) + bf_hi(v.z) * bf_hi(v.z) + bf_lo(v.w) * bf_lo(v.w) + bf_hi(v.w) * bf_hi(v.w);
            if (kind == 0) { const u32x4 w = *(const u32x4*)(base + 1024 + d0 * 16);
                dot += bf_lo(v.x) * bf_lo(w.x) + bf_hi(v.x) * bf_hi(w.x) + bf_lo(v.y) * bf_lo(w.y) + bf_hi(v.y) * bf_hi(w.y) + bf_lo(v.z) * bf_lo(w.z) + bf_hi(v.z) * bf_hi(w.z) + bf_lo(v.w) * bf_lo(w.w) + bf_hi(v.w) * bf_hi(w.w); } }
        ss += shx(ss, 32, lane); dot += shx(dot, 32, lane);
        float nd = fmaxf(-dot, 0.f);
#pragma unroll
        for (int o = 1; o < 32; o <<= 1) { ss = fmaxf(ss, shx(ss, o, lane)); nd = fmaxf(nd, shx(nd, o, lane)); }
        if (lane == 0) { __hip_atomic_fetch_max(NRM + (kind ? 1024 + combo : combo * 16 + qb), __float_as_uint(ss * 1.0001f), __ATOMIC_RELAXED, __HIP_MEMORY_SCOPE_AGENT);
            if (kind == 0) __hip_atomic_fetch_max(NRM + 1088 + combo * 16 + qb, __float_as_uint(nd * 1.0001f + 0.01f), __ATOMIC_RELAXED, __HIP_MEMORY_SCOPE_AGENT); }
    }
}

__device__ __forceinline__ float slope_pow2_half(int k) { return __builtin_amdgcn_exp2f(-(float)(k >> 1)) * ((k & 1) ? 0.70710678118654752f : 1.0f); }
__device__ __forceinline__ void phase_attention(const Args& a, int l, LAS unsigned char* lds, int G, int bx, const int wave0, const int part  ) {
    LAS char* L = (LAS char*)lds;
    const int nband = (l == 0) ? 3072 : 2048;
    int cv_n = (part == 2) ? 2 * ((nband - bx + G - 1) / G) : 0;
#define CV_ITEMS(K) do { { const int cvl_ = ({ int l_; asm volatile("v_mbcnt_lo_u32_b32 %0, -1, 0\n\tv_mbcnt_hi_u32_b32 %0, -1, %0" : "=v"(l_)); l_; }); LAS float* cvs_ = (LAS float*)(lds + wave0 * 8448); \
        for (int q_ = 0; q_ < (K); ++q_) { const int it_ = (bx + cv_n * G) * 8 + wave0; if (it_ >= 48 * 2048) break; conv_ffn_item(a, l, it_, cvs_, cvl_); ++cv_n; } } } while (0)
    if (part & 1) {
    for (int repB_ = 0; repB_ < PH_REP(13); ++repB_)
    for (int i = 0; ; ++i) { const int u = i * G + bx; if (u >= nband) break;
        const bf16_t *Qb, *Kt, *Vt; bf16_t* Ob; float* Lb; int ldq, ldo, ldl; int q0, n, rad; float slope, sinkR;
        if (l == 0) {
            const bf16_t* P = (const bf16_t*)(a.ws + WS_R1);
            const int br = u >> 10, rem = u & 1023, b = rem >> 7, h = (rem >> 4) & 7, j = rem & 15;
            const int d = br == 0 ? 1 : (br == 1 ? 4 : 16), res = j & (d - 1), qb = br == 0 ? j : (br == 1 ? (j >> 2) : 0);
            n = SEQ / d; q0 = qb * 256; rad = 64; ldq = d * AB_IN; ldo = d * 512; ldl = d * 8;
            const size_t tok0 = (size_t)b * SEQ + res;
            Qb = P + tok0 * AB_IN + 3072 + h * 128; Kt = P + tok0 * AB_IN + 4096 + h * 128; Vt = P + tok0 * AB_IN + 5120 + h * 128;
            Ob = (bf16_t*)((unsigned char*)(a.ws + WS_R2) + (size_t)br * T * 1024 + tok0 * 1024 + h * 128);
            Lb = (float*)(a.ws + WS_LSE) + (size_t)br * T * 8 + tok0 * 8 + h;
            slope = __builtin_amdgcn_exp2f(-(float)(h + 1)) * (float)d; sinkR = -INFINITY;
        } else {
            const bf16_t* P = (const bf16_t*)(a.ws + WS_R1);
            const int combo = (u >> 9) * 8 + (u & 7), sub = (u & 511) >> 3, b = combo >> 2, kvh = combo & 3, g = sub >> 4, qb = sub & 15, hq = kvh * 4 + g;
            n = SEQ; q0 = qb * 256; rad = 128; ldq = C_IN; ldo = DM / 2; ldl = 0;
            const size_t tok0 = (size_t)b * SEQ;
            Qb = P + tok0 * C_IN + hq * 128; Kt = P + tok0 * C_IN + 2048 + kvh * 128; Vt = P + tok0 * C_IN + 2560 + kvh * 128;
            Ob = (bf16_t*)((unsigned char*)(a.ws + WS_HB) + tok0 * DM + hq * 128); Lb = nullptr;
            slope = slope_pow2_half(hq + 1); { float l2e_ = 1.4426950408889634f; asm volatile("" : "+s"(l2e_)); sinkR = a.in[IN_CSINK][hq] * l2e_; }
        }
        const int nt_tot = n / 64, nblk = rad / 64;
        int t_lo = q0 / 64 - nblk; if (t_lo < 0) t_lo = 0;
        int t_hi = q0 / 64 + 4 + nblk; if (t_hi > nt_tot) t_hi = nt_tot;
        if ((t_hi - t_lo) & 1) { if (t_hi < nt_tot) ++t_hi; else --t_lo; }
        att::attn_unit<true>(Qb + (long)(q0 * ldq), ldq, Kt + (long)(t_lo * 64 * ldq), Vt + (long)(t_lo * 64 * ldq), ldq, Ob + (long)(q0 * ldo), ldo,
                             Lb ? Lb + (long)(q0 * ldl) : nullptr, ldl, q0 - t_lo * 64, t_hi - t_lo, -slope * 1.4426950408889634f, (float)rad, sinkR, L, wave0, true);
        cv_n = (l == 0 ? 2 : 6) * i; CV_ITEMS(l == 0 ? 2 : 6);
        if (l == 0 && bx + i * G < 2048) norms_item(a, bx + i * G, wave0);
    }
    if (l == 0) for (int n_ = (nband - bx + G - 1) / G; bx + n_ * G < 2048; ++n_) norms_item(a, bx + n_ * G, wave0);
    cv_n = (l == 0 ? 2 : 6) * ((nband - bx + G - 1) / G);
    }
    for (int repA_ = 0; repA_ < PH_REP(12); ++repA_)
    if (l == 0 && (part & 2)) {
        const bf16_t* P = (const bf16_t*)(a.ws + WS_R1); bf16_t* OA = (bf16_t*)(a.ws + WS_R3);
        const unsigned* NRM = (const unsigned*)(a.ws + WS_CTL) + CW_NRM;
        for (int i = 0; ; ++i) { const int u = i * G + bx; if (u >= 1024) break;
            const int rnd = u >> 8, x = u & 7, sub = (u & 255) >> 3, b = 2 * rnd + (sub >> 4), h = ((x >> 1) + rnd) & 3, map = x & 1, qb = (rnd & 2) ? 15 - (sub & 15) : (sub & 15), combo = (b * 4 + h) * 2 + map;
            const float slope = __builtin_amdgcn_exp2f(-2.0f * (float)(h + 1));
            const float smax2 = sqrtf(__uint_as_float(NRM[combo * 16 + qb]) * __uint_as_float(NRM[1024 + combo]));
            const float sl2 = slope * 1.4426950408889634f;
            const float mlb2 = -__uint_as_float(NRM[1088 + combo * 16 + qb]);
            const float dmf = fminf((smax2 - mlb2 + 43.3f) / sl2 + 1.0f, 65536.0f); const int dmax = (int)dmf, q0 = qb * 256;
            int lo = q0 - dmax; if (lo < 0) lo = 0; const int t_lo = lo >> 6; int t_hi = ((q0 + 255 + dmax) >> 6) + 1; if (t_hi > SEQ / 64) t_hi = SEQ / 64;
            const bf16_t* Qb = P + (size_t)(b * SEQ + q0) * AB_IN + (h * 2 + map) * 128;
            const bf16_t* Kt = P + (size_t)(b * SEQ + t_lo * 64) * AB_IN + 1024 + (h * 2 + map) * 128;
            const bf16_t* Vt = P + (size_t)(b * SEQ + t_lo * 64) * AB_IN + 2048 + h * 256;
            bf16_t* Ob = OA + (size_t)(b * SEQ + q0) * DM + (h * 2 + map) * 256;
            att::attn_unit256(Qb, AB_IN, Kt, Vt, AB_IN, Ob, DM, q0 - t_lo * 64, t_hi - t_lo, -sl2, L, wave0);
            CV_ITEMS(6);
        }
    }
    if (part & 2) CV_ITEMS(48 * 2048);
}

#undef CV_ITEMS
__device__ __forceinline__ void phase_combine(const Args& a, int l, int lane, int wave, int vcu, int G) {
    bf16_t* Y = (bf16_t*)(a.ws + WS_HB);
    const int gw = vcu * 8 + wave, NGW = G * 8;
    if (l == 0) {
        const float* dl = a.in[IN_DLAM];
        const float d01 = wave_sum(dl[lane] * dl[128 + lane] + dl[64 + lane] * dl[192 + lane], lane);
        const float d23 = wave_sum(dl[256 + lane] * dl[384 + lane] + dl[320 + lane] * dl[448 + lane], lane);
        const float lam = expf(d01) - expf(d23) + LAM_INIT0;
        const f32x4 g4 = *(const f32x4*)(a.in[IN_SUBLN] + 4 * lane) * (1.0f - LAM_INIT0);
        const bf16_t* OA = (const bf16_t*)(a.ws + WS_R3); const unsigned char* OB = (const unsigned char*)(a.ws + WS_R2); const float* LSE = (const float*)(a.ws + WS_LSE);
        u32x2 an[8]; u32x4 bn[3]; float ln_[3];
#define CMB_LOAD(row_) do { const bf16_t* oa_ = OA + (size_t)(row_) * DM; const int hb_ = lane >> 3; \
            _Pragma("unroll") for (int h = 0; h < 4; ++h) { an[2 * h] = *(const u32x2*)(oa_ + h * 512 + 4 * lane); an[2 * h + 1] = *(const u32x2*)(oa_ + h * 512 + 256 + 4 * lane); } \
            { const size_t off_ = (size_t)(row_) * 1024 + 16 * lane; bn[0] = *(const u32x4*)(OB + off_); bn[1] = *(const u32x4*)(OB + (size_t)T * 1024 + off_); bn[2] = *(const u32x4*)(OB + (size_t)2 * T * 1024 + off_); } \
            ln_[0] = LSE[(size_t)(row_) * 8 + hb_]; ln_[1] = LSE[(size_t)T * 8 + (size_t)(row_) * 8 + hb_]; ln_[2] = LSE[(size_t)2 * T * 8 + (size_t)(row_) * 8 + hb_]; } while (0)
        asm volatile("" :: "v"(g4), "v"(lam));
        if (gw < T) CMB_LOAD(gw);
#pragma unroll 1
        for (int row = gw; row < T; row += NGW) {
            bf16_t* y = Y + (size_t)row * DM;
            u32x2 ac[8]; u32x4 bc[3];
#pragma unroll
            for (int k = 0; k < 8; ++k) ac[k] = an[k];
#pragma unroll
            for (int k = 0; k < 3; ++k) bc[k] = bn[k];
            const float l0 = ln_[0], l1 = ln_[1], l2 = ln_[2];
            if (row + NGW < T) CMB_LOAD(row + NGW);
#pragma unroll
            for (int h = 0; h < 4; ++h) { const u32x2 a0 = ac[2 * h], a1 = ac[2 * h + 1];
                const f32x4 o0 = {bf_lo(a0.x), bf_hi(a0.x), bf_lo(a0.y), bf_hi(a0.y)}, o1 = {bf_lo(a1.x), bf_hi(a1.x), bf_lo(a1.y), bf_hi(a1.y)};
                const f32x4 dd = o0 - o1 * lam; const float ss = wave_sum_v(dd[0] * dd[0] + dd[1] * dd[1] + dd[2] * dd[2] + dd[3] * dd[3]);
                const float rs = 1.0f / sqrtf(ss * (1.0f / 256.0f) + LN_EPS); const f32x4 r = dd * rs * g4;
                u32x2 w; w.x = cvtpk(r[0], r[1]); w.y = cvtpk(r[2], r[3]); *(u32x2*)(y + h * 256 + 4 * lane) = w; }
            const float mx = fmaxf(l0, fmaxf(l1, l2)); const float e0 = expf(l0 - mx), e1 = expf(l1 - mx), e2 = expf(l2 - mx); const float inv = 1.0f / (e0 + e1 + e2);
            const float w0 = e0 * inv * (1.0f / YATT_SCALE), w1 = e1 * inv * (1.0f / YATT_SCALE), w2 = e2 * inv * (1.0f / YATT_SCALE);
            u32x4 wv[2];
#pragma unroll
            for (int d = 0; d < 4; ++d) {
                const f32x2 x0 = __builtin_amdgcn_cvt_pk_f32_fp8((int)bc[0][d], false), x1 = __builtin_amdgcn_cvt_pk_f32_fp8((int)bc[0][d], true);
                const f32x2 y0 = __builtin_amdgcn_cvt_pk_f32_fp8((int)bc[1][d], false), y1 = __builtin_amdgcn_cvt_pk_f32_fp8((int)bc[1][d], true);
                const f32x2 z0 = __builtin_amdgcn_cvt_pk_f32_fp8((int)bc[2][d], false), z1 = __builtin_amdgcn_cvt_pk_f32_fp8((int)bc[2][d], true);
                const f32x2 s0 = x0 * w0 + y0 * w1 + z0 * w2, s1 = x1 * w0 + y1 * w1 + z1 * w2;
                wv[d >> 1][(d & 1) * 2] = cvtpk(s0.x, s0.y); wv[d >> 1][(d & 1) * 2 + 1] = cvtpk(s1.x, s1.y); }
            *(u32x4*)(y + 1024 + 16 * lane) = wv[0]; *(u32x4*)(y + 1024 + 16 * lane + 8) = wv[1];
        }
#undef CMB_LOAD
    }
}

#define LDS_BARRIER() asm volatile("s_waitcnt lgkmcnt(0)\n\ts_barrier" ::: "memory")
constexpr int RP = 1;
__device__ __forceinline__ void phase_ln1_router(const Args& a, int l, const float* __restrict__ X, LAS unsigned char* lds, int tid, int lane, int wave, int vcu, int G) {
    const bool xh = l != 0; const unsigned short* Xh = (const unsigned short*)(a.ws + WS_X1) + (size_t)T * DM;
    const float* MOD = (const float*)(a.ws + WS_MOD); const bf16_t* YO = (const bf16_t*)(a.ws + WS_R3);
    unsigned short* X1 = (unsigned short*)(a.ws + WS_X1); unsigned char* HB = (unsigned char*)(a.ws + WS_HB); float* AFF = (float*)(a.ws + WS_AFF);
    LAS f32x4* WL = (LAS f32x4*)lds;
    LAS f32x2* stat = (LAS f32x2*)(lds + 132096);
    LAS float* plog = (LAS float*)(lds + 132096 + 256);
    const int pr = wave >> 1, hf = wave & 1;
    { const float* Wr = a.in[IN_ROUTER] + (size_t)l * DM * NE;
      for (int i = tid; i < DM * 4; i += 512) { const int col = i >> 2, q = i & 3; const f32x4 w = *(const f32x4*)(Wr + (size_t)col * NE + 4 * q);
          WL[((((col >> 10) * 4 + ((col >> 8) & 3)) * 4 + (col & 3)) * 4 + q) * 64 + ((col & 255) >> 2)] = w; } }
    f32x4 lng[4], lnb[4];
#pragma unroll
    for (int j = 0; j < 4; ++j) { const int c = 1024 * hf + 256 * j + 4 * lane; lng[j] = *(const f32x4*)(a.in[IN_LNG] + (size_t)(l * 2 + 0) * DM + c); lnb[j] = *(const f32x4*)(a.in[IN_LNB] + (size_t)(l * 2 + 0) * DM + c); }
    asm volatile("" :: "v"(lng[0]), "v"(lng[1]), "v"(lng[2]), "v"(lng[3]), "v"(lnb[0]), "v"(lnb[1]), "v"(lnb[2]), "v"(lnb[3]));
    __syncthreads();
    const LAS f32x4* wl = WL + hf * (16 * 4 * 64) + lane;
    for (int blk = vcu; blk < T / 128; blk += G) {
        const int b = blk >> 5; const float* mb = MOD + (size_t)(l * 8 + b) * (6 * DM);
        f32x4 g1[4], sh2[4], sc2[4];
#pragma unroll
        for (int j = 0; j < 4; ++j) { const int c = 1024 * hf + 256 * j + 4 * lane; g1[j] = *(const f32x4*)(mb + 2 * DM + c); sh2[j] = *(const f32x4*)(mb + 3 * DM + c); sc2[j] = *(const f32x4*)(mb + 4 * DM + c) + 1.0f; }
        asm volatile("" :: "v"(g1[0]), "v"(g1[1]), "v"(g1[2]), "v"(g1[3]), "v"(sh2[0]), "v"(sh2[1]), "v"(sh2[2]), "v"(sh2[3]), "v"(sc2[0]), "v"(sc2[1]), "v"(sc2[2]), "v"(sc2[3]));
        f32x4 xr[RP][4]; u32x2 yr[RP][4];
#pragma unroll
        for (int i = 0; i < RP; ++i)
#pragma unroll
            for (int j = 0; j < 4; ++j) { const size_t off = (size_t)(blk * 128 + pr * RP + i) * DM + 1024 * hf + 256 * j + 4 * lane; if (xh) { const u32x2 t_ = *(const u32x2*)(Xh + off); xr[i][j] = (f32x4){__uint_as_float(t_.x), __uint_as_float(t_.y), 0.f, 0.f}; } else xr[i][j] = *(const f32x4*)(X + off); if (xh) yr[i][j] = (u32x2){*(const unsigned*)((const unsigned char*)YO + off), 0u}; else yr[i][j] = *(const u32x2*)(YO + off); }
#pragma unroll 1
        for (int bt = 0; bt < 32 / RP; ++bt) {
            const int row0 = blk * 128 + bt * (4 * RP) + pr * RP;
            f32x4 v[RP][4];
#pragma unroll
            for (int i = 0; i < RP; ++i)
#pragma unroll
                for (int j = 0; j < 4; ++j) { f32x4 y = {bf_lo(yr[i][j].x), bf_hi(yr[i][j].x), bf_lo(yr[i][j].y), bf_hi(yr[i][j].y)};
                    if (xh) { const f32x2 ya_ = __builtin_amdgcn_cvt_pk_f32_fp8((int)yr[i][j].x, false), yb_ = __builtin_amdgcn_cvt_pk_f32_fp8((int)yr[i][j].x, true); y = (f32x4){ya_.x, ya_.y, yb_.x, yb_.y} * (1.0f / YO1_SCALE); }
                    f32x4 xv = xr[i][j]; if (xh) { const unsigned a_ = __float_as_uint(xv[0]), b_ = __float_as_uint(xv[1]); xv = (f32x4){h_lo(a_), h_hi(a_), h_lo(b_), h_hi(b_)}; }
                    v[i][j] = xv * ALPHA + g1[j] * y; }
            if (bt + 1 < 32 / RP) {
#pragma unroll
                for (int i = 0; i < RP; ++i)
#pragma unroll
                    for (int j = 0; j < 4; ++j) { const size_t off = (size_t)(row0 + 4 * RP + i) * DM + 1024 * hf + 256 * j + 4 * lane; if (xh) { const u32x2 t_ = *(const u32x2*)(Xh + off); xr[i][j] = (f32x4){__uint_as_float(t_.x), __uint_as_float(t_.y), 0.f, 0.f}; } else xr[i][j] = *(const f32x4*)(X + off); if (xh) yr[i][j] = (u32x2){*(const unsigned*)((const unsigned char*)YO + off), 0u}; else yr[i][j] = *(const u32x2*)(YO + off); } }
#pragma unroll
            for (int i = 0; i < RP; ++i) { const f32x4 s4 = (v[i][0] + v[i][1]) + (v[i][2] + v[i][3]); const float mw = wave_sum_v((s4[0] + s4[1]) + (s4[2] + s4[3])) * (1.0f / 1024.0f);
                f32x4 q4 = {0.f, 0.f, 0.f, 0.f};
#pragma unroll
                for (int j = 0; j < 4; ++j) { const f32x4 d = v[i][j] - mw; q4 += d * d; }
                const float q = wave_sum_v((q4[0] + q4[1]) + (q4[2] + q4[3]));
                if (lane == 0) stat[(pr * RP + i) * 2 + hf] = (f32x2){mw, q}; }
            LDS_BARRIER();
            f32x4 p[RP][4];
#pragma unroll
            for (int i = 0; i < RP; ++i) {
                const f32x2 s0 = stat[(pr * RP + i) * 2], s1 = stat[(pr * RP + i) * 2 + 1];
                const float mean = (s0[0] + s1[0]) * 0.5f, d0 = s0[0] - mean, d1 = s1[0] - mean, m2 = (s0[1] + s1[1]) + 1024.0f * (d0 * d0 + d1 * d1);
                const float rstd = 1.0f / sqrtf(m2 * (1.0f / 2048.0f) + LN_EPS);
#pragma unroll
                for (int j = 0; j < 4; ++j) { const f32x4 x1 = (v[i][j] - mean) * rstd * lng[j] + lnb[j]; const f32x4 h2 = x1 * sc2[j] + sh2[j];
                    const size_t off = (size_t)(row0 + i) * DM + 1024 * hf + 256 * j + 4 * lane;
                    *(u32x2*)(X1 + off) = (u32x2){pkh(x1[0], x1[1]), pkh(x1[2], x1[3])};
                    const f32x4 hs = __builtin_elementwise_min(__builtin_elementwise_max(h2 * H2_SCALE, (f32x4){-448.f, -448.f, -448.f, -448.f}), (f32x4){448.f, 448.f, 448.f, 448.f});
                    int hw = __builtin_amdgcn_cvt_pk_fp8_f32(hs[0], hs[1], 0, false); hw = __builtin_amdgcn_cvt_pk_fp8_f32(hs[2], hs[3], hw, true);
                    *(int*)(HB + off) = hw;
                    v[i][j] = h2; }
#pragma unroll
                for (int q = 0; q < 4; ++q) p[i][q] = (f32x4){0.f, 0.f, 0.f, 0.f};
            }
#pragma unroll
            for (int j = 0; j < 4; ++j)
#pragma unroll
                for (int t = 0; t < 4; ++t) {
                    f32x4 w[4];
#pragma unroll
                    for (int q = 0; q < 4; ++q) w[q] = wl[((j * 4 + t) * 4 + q) * 64];
#pragma unroll
                    for (int i = 0; i < RP; ++i)
#pragma unroll
                        for (int q = 0; q < 4; ++q) p[i][q] += w[q] * v[i][j][t];
                    if (t & 1) asm volatile("" ::: "memory"); }
#pragma unroll
            for (int i = 0; i < RP; ++i) { float t8[8], t4[4], t2[2];
#pragma unroll
                for (int k = 0; k < 8; ++k) t8[k] = swap32_add(p[i][k >> 2][k & 3], p[i][2 + (k >> 2)][k & 3]);
#pragma unroll
                for (int k = 0; k < 4; ++k) t4[k] = swap16_add(t8[k], t8[4 + k]);
                const bool up3 = (lane & 8) != 0;
#pragma unroll
                for (int k = 0; k < 2; ++k) { const float mine = up3 ? t4[2 + k] : t4[k], theirs = up3 ? t4[k] : t4[2 + k]; t2[k] = sum8_dpp(mine + dpp_mov<0x128>(theirs)); }
                if ((lane & 7) == 0) *(LAS f32x2*)(plog + ((pr * RP + i) * 2 + hf) * 16 + (lane >> 3) * 2) = (f32x2){t2[0], t2[1]}; }
            LDS_BARRIER();
            if (lane < 16 && wave < 4 * RP) { const int r8 = wave; const float lg = plog[(r8 * 2) * 16 + lane] + plog[(r8 * 2 + 1) * 16 + lane];
                float mx = lg;
#pragma unroll
                for (int o = 1; o < 16; o <<= 1) mx = fmaxf(mx, shx(mx, o, lane));
                const float ex = expf(lg - mx); float sm = ex;
#pragma unroll
                for (int o = 1; o < 16; o <<= 1) sm += shx(sm, o, lane);
                const int row = blk * 128 + bt * (4 * RP) + r8; AFF[((size_t)(b * NE + lane)) * SEQ + (row & (SEQ - 1))] = ex / sm; }
        }
        LDS_BARRIER();
    }
    __syncthreads();
}

__device__ __forceinline__ int block_excl_scan(int v, LAS int* wsum, int lane, int wave, int& total) {
    int x = v;
#pragma unroll
    for (int o = 1; o < 64; o <<= 1) { const int y = shup_i(x, o, lane); if (lane >= o) x += y; }
    if (lane == 63) wsum[wave] = x;
    __syncthreads();
    int off = 0, tot = 0;
#pragma unroll
    for (int w = 0; w < 8; ++w) { const int s = wsum[w]; off += (w < wave) ? s : 0; tot += s; }
    __syncthreads();
    total = tot; return off + x - v;
}
__device__ __forceinline__ void phase_topk(const Args& a, LAS unsigned char* lds, int tid, int lane, int wave, int G, int bx) {
    const float* AFF = (const float*)(a.ws + WS_AFF); int* IDX = (int*)(a.ws + WS_IDX); int* INVC = (int*)(a.ws + WS_INVC); float* INVG = (float*)(a.ws + WS_INVG);
    LAS unsigned* hist = (LAS unsigned*)lds;
    LAS int* wsum = (LAS int*)(lds + 1024);
    LAS int* selw = (LAS int*)(lds + 1024 + 64);
    for (int it = bx; it < NB * NE; it += G) {
        const int b = it >> 4, e = it & 15;
        const float* av = AFF + (size_t)it * SEQ + 8 * tid;
        const f32x4 v0 = *(const f32x4*)av, v1 = *(const f32x4*)(av + 4);
        unsigned u[8] = {__float_as_uint(v0[0]), __float_as_uint(v0[1]), __float_as_uint(v0[2]), __float_as_uint(v0[3]), __float_as_uint(v1[0]), __float_as_uint(v1[1]), __float_as_uint(v1[2]), __float_as_uint(v1[3])};
        unsigned prefix = 0u; int kk = CAP;
#pragma unroll
        for (int pass = 0; pass < 4; ++pass) {
            const int shift = 24 - 8 * pass; const unsigned mhi = pass == 0 ? 0u : (0xFFFFFFFFu << (shift + 8));
            if (tid < 256) hist[tid] = 0u;
            __syncthreads();
#pragma unroll
            for (int i = 0; i < 8; ++i) if ((u[i] & mhi) == prefix) __hip_atomic_fetch_add(&hist[(u[i] >> shift) & 255u], 1u, __ATOMIC_RELAXED, __HIP_MEMORY_SCOPE_WORKGROUP);
            __syncthreads();
            const int bin = 255 - tid; const int h = tid < 256 ? (int)hist[bin] : 0; int tot;
            const int excl = block_excl_scan(h, wsum, lane, wave, tot);
            if (tid < 256 && excl < kk && kk <= excl + h) { selw[0] = bin; selw[1] = excl; }
            __syncthreads();
            prefix |= (unsigned)selw[0] << shift; kk -= selw[1];
            __syncthreads();
        }
        int ngt = 0, neq = 0;
#pragma unroll
        for (int i = 0; i < 8; ++i) { ngt += u[i] > prefix ? 1 : 0; neq += u[i] == prefix ? 1 : 0; }
        int tgt, teq;
        int pg = block_excl_scan(ngt, wsum, lane, wave, tgt);
        int pe = block_excl_scan(neq, wsum, lane, wave, teq);
#pragma unroll
        for (int i = 0; i < 8; ++i) { const int s = 8 * tid + i; int c = -1;
            if (u[i] > prefix) c = pg++;
            else if (u[i] == prefix) { if (pe < kk) c = tgt + pe; ++pe; }
            const size_t tok = (size_t)b * SEQ + s;
            INVC[tok * NE + e] = c; INVG[tok * NE + e] = __uint_as_float(u[i]);
            if (c >= 0) IDX[(size_t)it * CAP + c] = (int)(((unsigned)b * SEQ + (unsigned)s) * (unsigned)DM); }
        __syncthreads();
    }
}

__device__ __forceinline__ void phase_gather(const Args& a, int lane, int wave, int vcu, int G) {
    const int* IDX = (const int*)(a.ws + WS_IDX); const bf16_t* HB = (const bf16_t*)(a.ws + WS_HB); bf16_t* XG = (bf16_t*)(a.ws + WS_R1);
    for (int slot = vcu * 8 + wave; slot < NSLOT; slot += G * 8) {
        const int b = slot >> 13, tok = IDX[slot]; const unsigned char* src = (const unsigned char*)HB + ((size_t)b * SEQ + tok) * DM; unsigned char* dst = (unsigned char*)XG + (size_t)slot * DM;
        u32x4 t[2];
#pragma unroll
        for (int j = 0; j < 2; ++j) t[j] = *(const u32x4*)(src + 16 * lane + 1024 * j);
#pragma unroll
        for (int j = 0; j < 2; ++j) *(u32x4*)(dst + 16 * lane + 1024 * j) = t[j];
    }
}

__device__ __forceinline__ void phase_ffn_combine(const Args& a, int l, float* __restrict__ OUT, LAS unsigned char* lds, int tid, int lane, int wave, int vcu, int G) {
    const float* MOD = (const float*)(a.ws + WS_MOD); const unsigned short* X1 = (const unsigned short*)(a.ws + WS_X1); const unsigned char* YD8 = (const unsigned char*)(a.ws + WS_R3);
    const int* INVC = (const int*)(a.ws + WS_INVC); const float* INVG = (const float*)(a.ws + WS_INVG); bf16_t* HB = (bf16_t*)(a.ws + WS_HB);
    LAS float* vg2 = (LAS float*)lds; LAS float* vlg = vg2 + DM; LAS float* vlb = vlg + DM; LAS float* vsc = vlb + DM; LAS float* vsh = vsc + DM;
    for (int blk = vcu; blk < T / 128; blk += G) {
        const int b = blk >> 5; const float* mb = MOD + (size_t)(l * 8 + b) * (6 * DM); const float* mbn = MOD + (size_t)(8 + b) * (6 * DM);
        __syncthreads();
        for (int i = tid; i < DM; i += 512) { vg2[i] = mb[5 * DM + i]; vlg[i] = a.in[IN_LNG][(size_t)(l * 2 + 1) * DM + i]; vlb[i] = a.in[IN_LNB][(size_t)(l * 2 + 1) * DM + i];
            vsc[i] = mbn[DM + i] + 1.0f; vsh[i] = mbn[i]; }
        __syncthreads();
        int ic_n = lane < 16 ? INVC[(size_t)(blk * 128 + wave * 16) * NE + lane] : -1; float ig_n = lane < 16 ? INVG[(size_t)(blk * 128 + wave * 16) * NE + lane] : 0.f;
        u32x4 xn_[4];
#pragma unroll
        for (int j = 0; j < 2; ++j)
#pragma unroll
            for (int q = 0; q < 2; ++q) xn_[2 * j + q] = *(const u32x4*)(X1 + (size_t)(blk * 128 + wave * 16) * DM + 16 * lane + 1024 * j + 8 * q);
#pragma unroll 1
        for (int r = 0; r < 16; ++r) {
            const int row = blk * 128 + wave * 16 + r;
            const int ic = ic_n; const float ig = ig_n; u32x4 xc[4];
#pragma unroll
            for (int j = 0; j < 4; ++j) xc[j] = xn_[j];
            if (r + 1 < 16) { ic_n = lane < 16 ? INVC[(size_t)(row + 1) * NE + lane] : -1; ig_n = lane < 16 ? INVG[(size_t)(row + 1) * NE + lane] : 0.f;
#pragma unroll
                for (int j = 0; j < 2; ++j)
#pragma unroll
                    for (int q = 0; q < 2; ++q) xn_[2 * j + q] = *(const u32x4*)(X1 + (size_t)(row + 1) * DM + 16 * lane + 1024 * j + 8 * q); }
            float y[32];
#pragma unroll
            for (int k = 0; k < 32; ++k) y[k] = 0.f;
            unsigned mask = (unsigned)__builtin_amdgcn_ballot_w64(ic >= 0) & 0xFFFFu;
            while (mask) {
                int ek[3]; float gk[3]; const unsigned char* yr[3];
#pragma unroll
                for (int k = 0; k < 3; ++k) { const bool ok = mask != 0u; const int e = ok ? __builtin_ctz(mask) : 0; if (ok) mask &= mask - 1u; ek[k] = e;
                    const int c = __builtin_amdgcn_readlane(ic, e); gk[k] = ok ? __uint_as_float((unsigned)__builtin_amdgcn_readlane((int)__float_as_uint(ig), e)) * (1.0f / YD_SCALE) : 0.f;
                    yr[k] = YD8 + ((size_t)(b * NE + e) * CAP + (ok ? c : 0)) * DM + 16 * lane; }
                u32x4 w[3][2];
#pragma unroll
                for (int k = 0; k < 3; ++k)
#pragma unroll
                    for (int j = 0; j < 2; ++j) w[k][j] = *(const u32x4*)(yr[k] + 1024 * j);
#pragma unroll
                for (int k = 0; k < 3; ++k)
#pragma unroll
                    for (int j = 0; j < 2; ++j) { const float gs = gk[k];
#pragma unroll
                        for (int d = 0; d < 4; ++d) { const f32x2 lo = __builtin_amdgcn_cvt_pk_f32_fp8((int)w[k][j][d], false), hi = __builtin_amdgcn_cvt_pk_f32_fp8((int)w[k][j][d], true);
                            y[16 * j + 4 * d + 0] += gs * lo[0]; y[16 * j + 4 * d + 1] += gs * lo[1]; y[16 * j + 4 * d + 2] += gs * hi[0]; y[16 * j + 4 * d + 3] += gs * hi[1]; } }
            }
            float v[32]; float s = 0.f;
#pragma unroll
            for (int j = 0; j < 2; ++j)
#pragma unroll
                for (int q = 0; q < 4; ++q) { const int col = 16 * lane + 1024 * j + 4 * q; const unsigned xw0 = xc[2 * j + (q >> 1)][(q & 1) * 2], xw1 = xc[2 * j + (q >> 1)][(q & 1) * 2 + 1]; const f32x4 xa = {h_lo(xw0), h_hi(xw0), h_lo(xw1), h_hi(xw1)}; const f32x4 ga = *(const LAS f32x4*)(vg2 + col);
#pragma unroll
                    for (int t = 0; t < 4; ++t) v[16 * j + 4 * q + t] = xa[t] * ALPHA + ga[t] * y[16 * j + 4 * q + t]; }
#pragma unroll
            for (int k = 0; k < 32; ++k) s += v[k];
            const float mean = wave_sum(s, lane) * (1.0f / DM); float q2 = 0.f;
#pragma unroll
            for (int k = 0; k < 32; ++k) { v[k] -= mean; q2 += v[k] * v[k]; }
            const float rstd = 1.0f / sqrtf(wave_sum(q2, lane) * (1.0f / DM) + LN_EPS);
#pragma unroll
            for (int j = 0; j < 2; ++j) { u32x4 hw;
#pragma unroll
                for (int q = 0; q < 4; ++q) { const int col = 16 * lane + 1024 * j + 4 * q;
                    const f32x4 la = *(const LAS f32x4*)(vlg + col), ba = *(const LAS f32x4*)(vlb + col);
                    f32x4 oa;
#pragma unroll
                    for (int t = 0; t < 4; ++t) oa[t] = v[16 * j + 4 * q + t] * rstd * la[t] + ba[t];
                    if (l == 0) *(u32x2*)((unsigned short*)(a.ws + WS_X1) + (size_t)T * DM + (size_t)row * DM + col) = (u32x2){pkh(oa[0], oa[1]), pkh(oa[2], oa[3])};
                    else *(f32x4*)(OUT + (size_t)row * DM + col) = oa;
                    if (l == 0) { const f32x4 sa = *(const LAS f32x4*)(vsc + col), ha = *(const LAS f32x4*)(vsh + col); const f32x4 h0 = oa * sa + ha;
                        const f32x4 hs = __builtin_elementwise_min(__builtin_elementwise_max(h0 * HIN1_SCALE, (f32x4){-448.f, -448.f, -448.f, -448.f}), (f32x4){448.f, 448.f, 448.f, 448.f});
                        unsigned w8; asm volatile("v_cvt_pk_fp8_f32 %0, %1, %2" : "=v"(w8) : "v"(hs[0]), "v"(hs[1])); asm volatile("v_cvt_pk_fp8_f32 %0, %1, %2 op_sel:[0,0,1]" : "+v"(w8) : "v"(hs[2]), "v"(hs[3])); hw[q] = w8; } }
                if (l == 0) *(u32x4*)((unsigned char*)HB + (size_t)row * DM + 16 * lane + 1024 * j) = hw; }
        }
    }
    if (l == 0) {
        __syncthreads();
        LAS float* scr = (LAS float*)(lds + wave * 16384);
        (void)scr;
    }
}

__device__ __forceinline__ Args load_args(unsigned long long kp) {
    const __attribute__((address_space(4))) Args* p = (const __attribute__((address_space(4))) Args*)kp;
    Args A;
#pragma unroll
    for (int i = 0; i < 17; ++i) A.in[i] = (const float*)(GAS const float*)(uintptr_t)p->in[i];
    A.out = (float*)(GAS float*)(uintptr_t)p->out; A.ws = (unsigned char*)(GAS unsigned char*)(uintptr_t)p->ws; A.ph_lo = p->ph_lo; A.ph_hi = p->ph_hi;
    return A;
}
constexpr int NPHASE = 22;
#ifndef PH_MASK
#define PH_MASK 0xFFF
#endif
#define PH_EN(k) ((((PH_MASK) >> (k)) & 1) != 0)

__global__ void __launch_bounds__(512, 2) fwd(Args args) {
    extern __shared__ __attribute__((aligned(16))) unsigned char lds_raw[];
    LAS unsigned char* lds = (LAS unsigned char*)lds_raw;
    const int tid0 = threadIdx.x; const int wave0 = __builtin_amdgcn_readfirstlane(tid0 >> 6);
#define LAUNDER() int tid = wave0 * 64 + ({ int l_; asm volatile("v_mbcnt_lo_u32_b32 %0, -1, 0\n\tv_mbcnt_hi_u32_b32 %0, -1, %0" : "=v"(l_)); l_; }); const int lane = tid & 63, wave = __builtin_amdgcn_readfirstlane(tid >> 6); (void)lane; (void)wave; LAUNDER_WS()
#define LAUNDER_WS() int bxl = bx, Gl = G; asm volatile("" : "+s"(bxl), "+s"(Gl)); const int vcul = (Gl % 8 == 0) ? (bxl % 8) * (Gl / 8) + bxl / 8 : bxl; (void)vcul; \
    unsigned long long kp_ = (unsigned long long)(uintptr_t)__builtin_amdgcn_kernarg_segment_ptr(); asm volatile("" : "+s"(kp_)); const Args A = load_args(kp_)
    const int G = gridDim.x; const int bx = blockIdx.x; const int vcu = (G % 8 == 0) ? (bx % 8) * (G / 8) + bx / 8 : bx;
    volatile LAS unsigned* MISC = (volatile LAS unsigned*)(lds + MISC_OFF);
    for (int u = tid0; u < (LDS_BYTES - RING_BYTES) / 4; u += 512) ((LAS unsigned*)(lds + RING_BYTES))[u] = 0u;
    __syncthreads();
    const int lo = args.ph_lo, hi = args.ph_hi;
    XcdBarrier bar; bar.bar = (unsigned*)(args.ws + WS_CTL) + CW_BAR; bar.x = 0; bar.st = nullptr;
    if (hi - lo > 1) bar = xcd_barrier_post((unsigned*)(args.ws + WS_CTL) + CW_BAR, MISC + 8);
#define IN(k) (lo <= (k) && (k) < hi)
#define BAR_SYNC() do { XcdBarrier b2_ = bar; { unsigned long long w_ = (unsigned long long)(uintptr_t)b2_.bar; asm volatile("" : "+s"(w_)); b2_.bar = (unsigned*)(GAS unsigned*)(uintptr_t)w_; } const int ln_ = ({ int l_; asm volatile("v_mbcnt_lo_u32_b32 %0, -1, 0\n\tv_mbcnt_hi_u32_b32 %0, -1, %0" : "=v"(l_)); l_; }); xcd_barrier(b2_, wave0 == 0 && ln_ == 0); } while (0)
#define SEAM(k) do { if (IN(k) && IN((k) + 1)) BAR_SYNC(); } while (0)

    for (int rep_ = 0; rep_ < PH_REP(0); ++rep_) if (PH_EN(0) && IN(0)) { if (rep_ > 0 && hi - lo > 1) BAR_SYNC(); LAUNDER(); phase_prologue(A, lds, tid, lane, wave, vcul, Gl, bxl); } SEAM(0);
    for (int rep_ = 0; rep_ < PH_REP(1); ++rep_) if (PH_EN(1) && IN(1)) { if (rep_ > 0 && hi - lo > 1) BAR_SYNC(); LAUNDER(); phase_modulate0(A, lane, wave, vcul, Gl); } SEAM(1);
    for (int l = 0; l < 2; ++l) {
        const int pb = 2 + 10 * l;
        for (int rep_ = 0; rep_ < PH_REP(2); ++rep_) if (PH_EN(2) && IN(pb + 0)) { if (rep_ > 0 && hi - lo > 1) BAR_SYNC();
            LAUNDER_WS(); const int N = l == 0 ? AB_IN : C_IN;
            pg8::StaticOrder S; S.init(T, C_IN, Gl, bxl);
            if (l == 0) { pg8::Gemm g{(const bf16_t*)(A.ws + WS_HB), (const bf16_t*)(A.ws + WS_WIN0), T, C_IN, DM, nullptr};
                pg8::EpiBf16 E{(bf16_t*)(A.ws + WS_R1), N, 0xFFFF, 1.0f};
                pg8::gemm_phase<pg8::EpiBf16, pg8::StaticOrder, true, true>(lds, g, S, E, wave0); }
            { pg8::Gemm g{(const bf16_t*)(A.ws + (l == 0 ? WS_R2 : WS_HB)), (const bf16_t*)(A.ws + (l == 0 ? WS_WIN0 + (size_t)3072 * DM * 2 : WS_WIN1)), T, C_IN, DM / 2, nullptr};
                pg8::EpiBf16 E{(bf16_t*)(A.ws + WS_R1) + (l == 0 ? 3072 : 0), N, 0xFFFF, 1.0f / (HIN1_SCALE * WIN1_SCALE)};
                pg8::gemm_phase<pg8::EpiBf16, pg8::StaticOrder, true, true, true>(lds, g, S, E, wave0); }
        } SEAM(pb + 0);
        for (int rep_ = 0; rep_ < PH_REP(3); ++rep_) if (PH_EN(3) && IN(pb + 1)) { if (rep_ > 0 && hi - lo > 1) BAR_SYNC(); for (int part_ = (l == 0 ? 1 : 3); part_ <= (l == 0 ? 2 : 3); ++part_) { if (part_ == 2) BAR_SYNC();     LAUNDER_WS(); phase_attention(A, l, lds, Gl, bxl, wave0, part_); } } SEAM(pb + 1);
        for (int rep_ = 0; rep_ < PH_REP(4); ++rep_) if (PH_EN(4) && IN(pb + 2) && l == 0) { if (rep_ > 0 && hi - lo > 1) BAR_SYNC(); LAUNDER(); phase_combine(A, l, lane, wave, vcul, Gl); } if (l == 0) SEAM(pb + 2);
        for (int rep_ = 0; rep_ < PH_REP(5); ++rep_) if (PH_EN(5) && IN(pb + 3)) { if (rep_ > 0 && hi - lo > 1) BAR_SYNC();
            LAUNDER_WS();
            pg8::StaticOrder S; S.init(T, DM, Gl, bxl);
            if (l == 0) { pg8::Gemm g{(const bf16_t*)(A.ws + WS_HB), (const bf16_t*)(A.ws + WS_WOUT0), T, DM, DM, nullptr};
                pg8::EpiBf16 E{(bf16_t*)(A.ws + WS_R3), DM, 0xFFFF, 1.0f};
                pg8::gemm_phase<pg8::EpiBf16, pg8::StaticOrder, true, true>(lds, g, S, E, wave0); }
            else { pg8::Gemm g{(const bf16_t*)(A.ws + WS_HB), (const bf16_t*)(A.ws + WS_WOUT1), T, DM, DM / 2, nullptr};
                pg8::EpiF8 E{(unsigned char*)(A.ws + WS_R3), DM, 0xFFFF, YO1_SCALE / (YATT_SCALE * WOUT_SCALE)};
                pg8::gemm_phase<pg8::EpiF8, pg8::StaticOrder, true, true, true>(lds, g, S, E, wave0); }
        } SEAM(pb + 3);
        for (int rep_ = 0; rep_ < PH_REP(6); ++rep_) if (PH_EN(6) && IN(pb + 4)) { if (rep_ > 0 && hi - lo > 1) BAR_SYNC(); LAUNDER(); phase_ln1_router(A, l, l == 0 ? A.in[IN_X] : (const float*)A.out, lds, tid, lane, wave, vcul, Gl); } SEAM(pb + 4);
        for (int rep_ = 0; rep_ < PH_REP(7); ++rep_) if (PH_EN(7) && IN(pb + 5)) { if (rep_ > 0 && hi - lo > 1) BAR_SYNC(); LAUNDER(); phase_topk(A, lds, tid, lane, wave, Gl, bxl); } SEAM(pb + 5);
        for (int rep_ = 0; rep_ < PH_REP(9); ++rep_) if (PH_EN(9) && IN(pb + 7)) { if (rep_ > 0 && hi - lo > 1) BAR_SYNC();
            LAUNDER_WS();
            pg8::Gemm g{(const bf16_t*)(A.ws + WS_HB), (const bf16_t*)(A.ws + WS_WGU), NSLOT, NE * 4096, DM / 2, (const unsigned*)(A.ws + WS_IDX)};
            pg8::GroupedOrder<16> S; S.init(Gl, bxl);
            pg8::EpiSwiGLU<true> E{(bf16_t*)(A.ws + WS_R2), EH, 15, HID_SCALE, 1.0f / (WGU_SCALE * H2_SCALE)};
            pg8::gemm_phase<pg8::EpiSwiGLU<true>, pg8::GroupedOrder<16>, true, true, true, true>(lds, g, S, E, wave0);
        } SEAM(pb + 7);
        for (int rep_ = 0; rep_ < PH_REP(10); ++rep_) if (PH_EN(10) && IN(pb + 8)) { if (rep_ > 0 && hi - lo > 1) BAR_SYNC();
            LAUNDER_WS();
            pg8::Gemm g{(const bf16_t*)(A.ws + WS_R2), (const bf16_t*)(A.ws + WS_WDN), NSLOT, NE * DM, EH / 2, nullptr};
            pg8::GroupedOrder<8> S; S.init(Gl, bxl);
            pg8::EpiF8 E{(unsigned char*)(A.ws + WS_R3), DM, 7, YD_SCALE / (WDN_SCALE * HID_SCALE)};
            pg8::gemm_phase<pg8::EpiF8, pg8::GroupedOrder<8>, true, true, true>(lds, g, S, E, wave0);
        } SEAM(pb + 8);
        for (int rep_ = 0; rep_ < PH_REP(11); ++rep_) if (PH_EN(11) && IN(pb + 9)) { if (rep_ > 0 && hi - lo > 1) BAR_SYNC(); LAUNDER(); phase_ffn_combine(A, l, A.out, lds, tid, lane, wave, vcul, Gl); } SEAM(pb + 9);
    }
#undef IN
#undef SEAM
#undef BAR_SYNC
}

extern "C" void kernel_launch(void* const* d_in, const int* in_sizes, int n_in, void* d_out, int out_size, void* d_ws, size_t ws_size, hipStream_t stream) {
    static int grid = 0;
    if (grid == 0) {
        if (n_in != 17 || out_size != T * DM || ws_size < WS_END) { fprintf(stderr, "kernel_launch: unexpected shapes (n_in %d out %d ws %zu, need ws >= %zu)\n", n_in, out_size, ws_size, (size_t)WS_END); grid = -1; return; }
        int dev = 0, cus = 0, per_cu = 0;
        if (hipGetDevice(&dev) != hipSuccess || hipDeviceGetAttribute(&cus, hipDeviceAttributeMultiprocessorCount, dev) != hipSuccess) { grid = -1; return; }
        if (hipFuncSetAttribute((const void*)fwd, hipFuncAttributeMaxDynamicSharedMemorySize, LDS_BYTES) != hipSuccess) { fprintf(stderr, "kernel_launch: hipFuncSetAttribute failed\n"); grid = -1; return; }
        if (hipOccupancyMaxActiveBlocksPerMultiprocessor(&per_cu, (const void*)fwd, 512, LDS_BYTES) != hipSuccess || per_cu < 1) fprintf(stderr, "kernel_launch: occupancy query says %d\n", per_cu);
        (void)hipGetLastError();
        grid = cus;
    }
    if (grid < 0) return;
    (void)hipMemsetAsync((char*)d_ws + WS_CTL, 0, CTL_ZERO_BYTES, stream);
    Args a{};
    for (int i = 0; i < 17; ++i) a.in[i] = (const float*)d_in[i];
    a.out = (float*)d_out; a.ws = (unsigned char*)d_ws;
#if MK_SINGLE
    a.ph_lo = 0; a.ph_hi = NPHASE;
    hipLaunchKernelGGL(fwd, dim3(grid), dim3(512), LDS_BYTES, stream, a);
#else
    for (int p = 0; p < NPHASE; ++p) { a.ph_lo = p; a.ph_hi = p + 1; hipLaunchKernelGGL(fwd, dim3(grid), dim3(512), LDS_BYTES, stream, a); }
#endif
}
```
